# Optimizing an MI355X kernel written in HIP

```python
import jax, jax.numpy as jnp
from jax import lax
import numpy as np

D_MODEL = 1024
BATCH = 1
SEQ = 16384
DEPTH = 4

D_MIX = D_MODEL
GLA_HEADS = 4
GLA_DV = 128
GLA_DK = 64
GLA_GATE_RANK = 16
GLA_GATE_NORMALIZER = 16.0
GLA_CHUNK = 64
GLA_WIDTH = GLA_HEADS * GLA_DV
LRU_WIDTH = D_MIX - GLA_WIDTH
LRU_BLOCKS = 8
LRU_BLOCK = LRU_WIDTH // LRU_BLOCKS
LRU_CONV = 4
LRU_C = 8.0
FFN_HIDDEN = 3 * D_MODEL
FFN_CONV = 3
EPS = 1e-6
Q_COLS = GLA_HEADS * GLA_DK
K_COLS = GLA_HEADS * GLA_DK
V_COLS = GLA_WIDTH
G_COLS = GLA_WIDTH
A_COLS = GLA_GATE_RANK
X_COLS = LRU_WIDTH
Y_COLS = LRU_WIDTH
D_IN = Q_COLS + K_COLS + V_COLS + G_COLS + A_COLS + X_COLS + Y_COLS
SPLITS = [Q_COLS, Q_COLS + K_COLS, Q_COLS + K_COLS + V_COLS,
          Q_COLS + K_COLS + V_COLS + G_COLS,
          Q_COLS + K_COLS + V_COLS + G_COLS + A_COLS,
          Q_COLS + K_COLS + V_COLS + G_COLS + A_COLS + X_COLS]

kernel_name = "hymba_gla_rglru_convffn_trunk"


def rmsnorm(x, g):
    xf = x.astype(jnp.float32)
    y = xf * lax.rsqrt(jnp.mean(xf * xf, axis=-1, keepdims=True) + EPS)
    return (y * g.astype(jnp.float32)).astype(x.dtype)


def causal_dwconv(x, w, b):
    K = w.shape[0]
    T = x.shape[1]
    xp = jnp.pad(x, ((0, 0), (K - 1, 0), (0, 0)))
    out = b
    for j in range(K):
        out = out + xp[:, j:j + T, :] * w[j]
    return out


def gla_heads(q, k, v, g_out, gate_lr, w2, b2, norm_g):
    f32 = jnp.float32
    Bsz, T, _ = q.shape
    N = T // GLA_CHUNK
    C = GLA_CHUNK
    log_alpha = jax.nn.log_sigmoid((gate_lr @ w2 + b2).astype(f32)) / GLA_GATE_NORMALIZER

    def chunks(t, d):
        return t.astype(f32).reshape(Bsz, N, C, GLA_HEADS, d).transpose(0, 3, 1, 2, 4)

    qc = chunks(q, GLA_DK) * (GLA_DK ** -0.5)
    kc = chunks(k, GLA_DK)
    vc = chunks(v, GLA_DV)
    gc = chunks(log_alpha, GLA_DK)
    b = jnp.cumsum(gc, axis=3)
    b_last = b[:, :, :, -1:, :]
    q_i = qc * jnp.exp(b)
    k_i = kc * jnp.exp(-b)
    k_dec = kc * jnp.exp(b_last - b)
    U = jnp.einsum('bhncd,bhnce->bhnde', k_dec, vc)
    decay = jnp.exp(b_last[:, :, :, 0, :])

    def step(S, inp):
        d_n, u_n = inp
        return d_n[..., None] * S + u_n, S

    S0 = jnp.zeros((Bsz, GLA_HEADS, GLA_DK, GLA_DV), f32)
    _, S_prev = lax.scan(step, S0, (jnp.moveaxis(decay, 2, 0), jnp.moveaxis(U, 2, 0)))
    S_prev = jnp.moveaxis(S_prev, 0, 2)
    mask = jnp.tril(jnp.ones((C, C), dtype=bool))
    A = jnp.where(mask, jnp.einsum('bhncd,bhnsd->bhncs', q_i, k_i), 0.0)
    o = (jnp.einsum('bhncs,bhnse->bhnce', A, vc)
         + jnp.einsum('bhncd,bhnde->bhnce', q_i, S_prev))
    o = o.transpose(0, 2, 3, 1, 4).reshape(Bsz, T, GLA_HEADS, GLA_DV)
    o = rmsnorm(o, norm_g)
    o = o * jax.nn.silu(g_out.astype(f32).reshape(Bsz, T, GLA_HEADS, GLA_DV))
    return o.reshape(Bsz, T, GLA_WIDTH).astype(q.dtype)


def rglru_heads(xr, xg, conv_w, conv_b, wa, ba, wx, bx, lam):
    f32 = jnp.float32
    Bsz, T, W = xr.shape
    xc = causal_dwconv(xr, conv_w, conv_b).astype(f32)
    xb = xc.reshape(Bsz, T, LRU_BLOCKS, LRU_BLOCK)
    r_gate = jax.nn.sigmoid(jnp.einsum('btnd,nde->btne', xb, wa.astype(f32)).reshape(Bsz, T, W) + ba)
    i_gate = jax.nn.sigmoid(jnp.einsum('btnd,nde->btne', xb, wx.astype(f32)).reshape(Bsz, T, W) + bx)
    log_a = -LRU_C * r_gate * jax.nn.softplus(-lam.astype(f32))
    a = jnp.exp(log_a)
    mult = jnp.sqrt(-jnp.expm1(2.0 * log_a))
    mult = jnp.where(jnp.arange(T)[None, :, None] == 0, 1.0, mult)
    u = mult * (i_gate * xc)

    def combine(left, right):
        a1, b1 = left
        a2, b2 = right
        return a1 * a2, a2 * b1 + b2

    _, h = lax.associative_scan(combine, (a, u), axis=1)
    y = h * jax.nn.gelu(xg.astype(f32))
    return y.astype(xr.dtype)


def conv_ffn(u, w_in, conv_w, conv_b, w_down):
    z = causal_dwconv(u @ w_in, conv_w, conv_b)
    a, gt = jnp.split(z, 2, axis=-1)
    return (jax.nn.gelu(a) * gt) @ w_down


def setup_inputs(seed: int = 0) -> dict:
    key = jax.random.key(seed)
    ks = jax.random.split(key, 24)
    f32 = jnp.float32
    nrm = lambda k, shape, s: jax.random.normal(k, shape, f32) * s
    u_lam = jax.random.uniform(ks[14], (DEPTH, LRU_WIDTH), f32, 0.9, 0.999)
    a0 = u_lam ** (1.0 / LRU_C)
    return {
        "x": jax.random.normal(ks[0], (BATCH, SEQ, D_MODEL), f32),
        "ln_mix": 1.0 + nrm(ks[1], (DEPTH, D_MODEL), 0.02),
        "w_in": nrm(ks[2], (DEPTH, D_MODEL, D_IN), D_MODEL ** -0.5),
        "gla_gate_w2": nrm(ks[3], (DEPTH, GLA_GATE_RANK, Q_COLS), GLA_GATE_RANK ** -0.5),
        "gla_gate_b": nrm(ks[4], (DEPTH, Q_COLS), 0.1),
        "gla_norm": 1.0 + nrm(ks[5], (DEPTH, GLA_DV), 0.02),
        "lru_conv_w": nrm(ks[6], (DEPTH, LRU_CONV, LRU_WIDTH), LRU_CONV ** -0.5),
        "lru_conv_b": nrm(ks[7], (DEPTH, LRU_WIDTH), 0.02),
        "lru_wa": nrm(ks[8], (DEPTH, LRU_BLOCKS, LRU_BLOCK, LRU_BLOCK), LRU_BLOCK ** -0.5),
        "lru_ba": nrm(ks[9], (DEPTH, LRU_WIDTH), 0.02),
        "lru_wx": nrm(ks[10], (DEPTH, LRU_BLOCKS, LRU_BLOCK, LRU_BLOCK), LRU_BLOCK ** -0.5),
        "lru_bx": nrm(ks[11], (DEPTH, LRU_WIDTH), 0.02),
        "lru_lambda": jnp.log(a0) - jnp.log1p(-a0),
        "w_out": nrm(ks[12], (DEPTH, D_MIX, D_MODEL), D_MIX ** -0.5),
        "ln_ffn": 1.0 + nrm(ks[13], (DEPTH, D_MODEL), 0.02),
        "ffn_w_in": nrm(ks[15], (DEPTH, D_MODEL, 2 * FFN_HIDDEN), D_MODEL ** -0.5),
        "ffn_conv_w": nrm(ks[16], (DEPTH, FFN_CONV, 2 * FFN_HIDDEN), FFN_CONV ** -0.5),
        "ffn_conv_b": nrm(ks[17], (DEPTH, 2 * FFN_HIDDEN), 0.02),
        "ffn_w_down": nrm(ks[18], (DEPTH, FFN_HIDDEN, D_MODEL), FFN_HIDDEN ** -0.5),
        "ln_final": 1.0 + nrm(ks[19], (D_MODEL,), 0.02),
    }


def reference(x, ln_mix, w_in, gla_gate_w2, gla_gate_b, gla_norm, lru_conv_w, lru_conv_b,
              lru_wa, lru_ba, lru_wx, lru_bx, lru_lambda, w_out, ln_ffn, ffn_w_in,
              ffn_conv_w, ffn_conv_b, ffn_w_down, ln_final):
    h = x
    for l in range(DEPTH):
        u = rmsnorm(h, ln_mix[l])
        proj = u @ w_in[l]
        q, k, v, g_out, gate_lr, lru_x, lru_g = jnp.split(proj, SPLITS, axis=-1)
        y_gla = gla_heads(q, k, v, g_out, gate_lr, gla_gate_w2[l], gla_gate_b[l], gla_norm[l])
        y_lru = rglru_heads(lru_x, lru_g, lru_conv_w[l], lru_conv_b[l], lru_wa[l], lru_ba[l],
                            lru_wx[l], lru_bx[l], lru_lambda[l])
        h = h + jnp.concatenate([y_gla, y_lru], axis=-1) @ w_out[l]
        u = rmsnorm(h, ln_ffn[l])
        h = h + conv_ffn(u, ffn_w_in[l], ffn_conv_w[l], ffn_conv_b[l], ffn_w_down[l])
    return rmsnorm(h, ln_final)
```

```cpp
#include <hip/hip_runtime.h>
#include <hip/hip_cooperative_groups.h>
#include <cstdio>
namespace cg = cooperative_groups;
namespace pg8 {
#define PG8_LAS __attribute__((address_space(3)))
typedef unsigned short bf16_t;
typedef short bf16x8 __attribute__((ext_vector_type(8)));
typedef float f32x4 __attribute__((ext_vector_type(4)));
typedef unsigned u32x4 __attribute__((ext_vector_type(4)));
constexpr int BM = 256, BK = 64, HALF = 128, HTB = HALF * BK * 2  , STAGE_BYTES = 8 * HTB, NXCD = 8, WGM = 8;

__host__ __device__ __forceinline__ int lds_byte(int r, int c) { const int st = (r >> 4) * 2 + (c >> 5), rr = r & 15, cc = c & 31, ob = rr * 64 + cc * 2; return st * 1024 + (ob ^ (((ob >> 9) & 1) << 5)); }
__host__ __device__ __forceinline__ void stage_rc(int b, int& R, int& C) { const int st = b / 1024, sb = b % 1024, swz = sb ^ (((sb >> 9) & 1) << 5); R = (st >> 1) * 16 + swz / 64; C = (st & 1) * 32 + (swz % 64) / 2; }
__host__ __device__ __forceinline__ int perm32(int rho) { const int n = rho >> 4, i = rho & 15; return 8 * (i >> 2) + 4 * n + (i & 3); }

struct Unit { int pm, pn; };
struct Gemm { const bf16_t* A; const bf16_t* Bt; int M, N, K; };

struct StaticOrder {
    int nM, nN, nwg, G, c;
    __host__ __device__ void init(int M, int N, int G_, int c_) { nM = M / BM; nN = N / BM; nwg = nM * nN; G = G_; c = c_; }
    __host__ __device__ bool next(int i, Unit& u) const {
        const long L = (long)i * G + c; if (L >= nwg) return false;
        int wgid = (int)L; { const int q = nwg / NXCD, r = nwg % NXCD, xcd = wgid % NXCD, off = wgid / NXCD; wgid = (xcd < r ? xcd * (q + 1) : r * (q + 1) + (xcd - r) * q) + off; }
        const int nig = WGM * nN, gid = wgid / nig, fm = gid * WGM, gsz = (nM - fm) < WGM ? (nM - fm) : WGM;
        u.pm = fm + ((wgid % nig) % gsz); u.pn = (wgid % nig) / gsz; return true;
    }
    __device__ __forceinline__ void a_ready(const Unit&) const {}
    __device__ __forceinline__ void done(const Unit&) const {}
};
__device__ __forceinline__ unsigned cvt_pk_bf16(float lo, float hi) { unsigned r; asm volatile("v_cvt_pk_bf16_f32 %0, %1, %2" : "=v"(r) : "v"(lo), "v"(hi)); return r; }
typedef float f32x2 __attribute__((ext_vector_type(2)));
__device__ __forceinline__ f32x2 gelu_pk(f32x2 v) {
    const f32x2 av = __builtin_elementwise_abs(v), d = av * 0.2316418882f + 1.0f;
    f32x2 t; t.x = __builtin_amdgcn_rcpf(d.x); t.y = __builtin_amdgcn_rcpf(d.y);
    f32x2 q = t * 0.5307027145f + (-0.7265760135f); q = q * t + 0.7107068705f; q = q * t + (-0.142248368f); q = q * t + 0.127414796f; q = q * t;
    const f32x2 s = (v * v) * (-0.72134752044f);
    f32x2 e; e.x = __builtin_amdgcn_exp2f(s.x); e.y = __builtin_amdgcn_exp2f(s.y);
    const f32x2 m = v * (q * e), r = v - m;
    f32x2 o; o.x = v.x < 0.f ? m.x : r.x; o.y = v.y < 0.f ? m.y : r.y; return o;
}

struct EpiF32 {
    static constexpr bool PERM = false, AFTER_DRAIN = false;
    float* C; int ldc; const float* bias;
    __device__ __forceinline__ void operator()(const f32x4 (&acc)[2][2][4][2], const Unit& u, int wr, int wc, int fr, int fq) const {
        const int row0 = u.pm * BM + wr * 64 + fr, col0 = u.pn * BM + wc * 32 + 4 * fq;
        f32x4 bv[2][2];
#pragma unroll
        for (int bj = 0; bj < 2; ++bj)
#pragma unroll
            for (int n = 0; n < 2; ++n) bv[bj][n] = bias ? *(const f32x4*)(bias + col0 + bj * HALF + n * 16) : (f32x4){0.f, 0.f, 0.f, 0.f};
#pragma unroll
        for (int ai = 0; ai < 2; ++ai)
#pragma unroll
            for (int m = 0; m < 4; ++m) { float* rowp = C + (size_t)(row0 + ai * HALF + m * 16) * ldc + col0;
#pragma unroll
                for (int bj = 0; bj < 2; ++bj)
#pragma unroll
                    for (int n = 0; n < 2; ++n) *(f32x4*)(rowp + bj * HALF + n * 16) = acc[ai][bj][m][n] + bv[bj][n]; }
    }
};
template <int ACT  > struct EpiBf16 {
    static constexpr bool PERM = true, AFTER_DRAIN = false;
    bf16_t* O; int ldc; const float* bias; int split_cols; size_t split_stride;
    __device__ __forceinline__ void operator()(const f32x4 (&acc)[2][2][4][2], const Unit& u, int wr, int wc, int fr, int fq) const {
        const int row0 = u.pm * BM + wr * 64 + fr; int colt = u.pn * BM; bf16_t* base = O;
        if (split_cols) { const int t = colt / split_cols; base += (size_t)t * split_stride; colt -= t * split_cols; }
        const int col0 = colt + wc * 32 + 8 * fq, bcol0 = u.pn * BM + wc * 32 + 8 * fq;
        f32x4 bv[2][2];
#pragma unroll
        for (int bj = 0; bj < 2; ++bj)
#pragma unroll
            for (int n = 0; n < 2; ++n) bv[bj][n] = bias ? *(const f32x4*)(bias + bcol0 + bj * HALF + 4 * n) : (f32x4){0.f, 0.f, 0.f, 0.f};
#pragma unroll
        for (int ai = 0; ai < 2; ++ai)
#pragma unroll
            for (int m = 0; m < 4; ++m) { bf16_t* rowp = base + (size_t)(row0 + ai * HALF + m * 16) * ldc + col0;
#pragma unroll
                for (int bj = 0; bj < 2; ++bj) { f32x4 v0 = acc[ai][bj][m][0] + bv[bj][0], v1 = acc[ai][bj][m][1] + bv[bj][1];
                    if (ACT == 1) { f32x2 a = gelu_pk((f32x2){v0[0], v0[1]}), b = gelu_pk((f32x2){v0[2], v0[3]}), c = gelu_pk((f32x2){v1[0], v1[1]}), d = gelu_pk((f32x2){v1[2], v1[3]});
                        v0 = (f32x4){a.x, a.y, b.x, b.y}; v1 = (f32x4){c.x, c.y, d.x, d.y}; }
                    if (ACT == 2) {
#pragma unroll
                        for (int j = 0; j < 4; ++j) { v0[j] = 0.5f * v0[j] * (1.0f + erff(v0[j] * 0.70710678f)); v1[j] = 0.5f * v1[j] * (1.0f + erff(v1[j] * 0.70710678f)); } }
                    u32x4 w; w.x = cvt_pk_bf16(v0[0], v0[1]); w.y = cvt_pk_bf16(v0[2], v0[3]); w.z = cvt_pk_bf16(v1[0], v1[1]); w.w = cvt_pk_bf16(v1[2], v1[3]);
                    *(u32x4*)(rowp + bj * HALF) = w; } }
    }
};
template <class Epi, class Sched, bool STAMP = false>
__device__ __forceinline__ void gemm_phase(PG8_LAS unsigned char* lds, const Gemm g, const Sched& S, const Epi& E, unsigned long long* stamps) {
    int tid_ = threadIdx.x; asm volatile("" : "+v"(tid_)); const int tid = tid_, wid = __builtin_amdgcn_readfirstlane(tid >> 6), lane = tid & 63, wr = wid >> 2, wc = wid & 3, fr = lane & 15, fq = lane >> 4;
    const int K = g.K, nt = K / BK;
    int ts_lo = 0, ts_hi = 0, nts = 0; const unsigned long long rt_entry = STAMP ? (unsigned long long)wall_clock64() : 0ull;
#define PG8_STAMP() do { if (STAMP && wid == 0 && nts < 64) { const unsigned long long _c = (unsigned long long)clock64(); \
        ts_lo = (lane == nts) ? (int)(unsigned)_c : ts_lo; ts_hi = (lane == nts) ? (int)(unsigned)(_c >> 32) : ts_hi; ++nts; } } while (0)
    PG8_STAMP();
    unsigned voffA[2], voffB[2];
#pragma unroll
    for (int i = 0; i < 2; ++i) { int R, C; stage_rc(tid * 16 + i * 8192, R, C); const int Rb = Epi::PERM ? ((R & ~31) + perm32(R & 31)) : R;
        voffA[i] = (unsigned)(R * K + C) * 2u; voffB[i] = (unsigned)(Rb * K + C) * 2u; }
    const size_t kstep = (size_t)(BK * 2);
    const size_t hstep = (size_t)HALF * K * 2;
    const size_t tstep = 2 * hstep;
    const unsigned ldsw = (unsigned)wid * 1024u;
    const int aoff = lds_byte(wr * 64 + fr, fq * 8), boff = lds_byte(wc * 32 + fr, fq * 8);
#define PG8_SA(b, h) (((b) * 2 + (h)) * HTB)
#define PG8_SB(b, h) ((4 + (b) * 2 + (h)) * HTB)
#define PG8_STAGE(bufoff, gbase, voff) do { _Pragma("unroll") for (int _i = 0; _i < 2; ++_i) \
        __builtin_amdgcn_global_load_lds((const unsigned*)((const char*)(gbase) + (voff)[_i]), (PG8_LAS unsigned*)(lds + (bufoff) + ldsw + _i * 8192), 16, 0, 0); } while (0)
#define PG8_LDA(dst, b, h) do { _Pragma("unroll") for (int m = 0; m < 4; ++m) _Pragma("unroll") for (int k = 0; k < 2; ++k) dst[m][k] = *(const PG8_LAS bf16x8*)(lds + PG8_SA(b, h) + aoff + m * 2048 + k * 1024); } while (0)
#define PG8_LDB(dst, b, h) do { _Pragma("unroll") for (int n = 0; n < 2; ++n) _Pragma("unroll") for (int k = 0; k < 2; ++k) dst[n][k] = *(const PG8_LAS bf16x8*)(lds + PG8_SB(b, h) + boff + n * 2048 + k * 1024); } while (0)
#define PG8_MMA(ai, bj, At, Bt) do { __builtin_amdgcn_s_setprio(1); _Pragma("unroll") for (int m = 0; m < 4; ++m) _Pragma("unroll") for (int n = 0; n < 2; ++n) _Pragma("unroll") for (int k = 0; k < 2; ++k) \
        acc[ai][bj][m][n] = __builtin_amdgcn_mfma_f32_16x16x32_bf16(Bt[n][k], At[m][k], acc[ai][bj][m][n], 0, 0, 0); __builtin_amdgcn_s_setprio(0); } while (0)
#define PG8_WAIT_V(n) asm volatile("s_waitcnt vmcnt(" #n ")" ::: "memory")
#define PG8_WAIT_L(n) asm volatile("s_waitcnt lgkmcnt(" #n ")" ::: "memory")
#define PG8_BAR __builtin_amdgcn_s_barrier()
#define PG8_SCHED __builtin_amdgcn_sched_barrier(0)
    Unit cur, nxt; int ui = 0;
    if (!S.next(0, cur)) return;
    f32x4 acc[2][2][4][2];
#pragma unroll
    for (int a = 0; a < 2; ++a)
#pragma unroll
        for (int b = 0; b < 2; ++b)
#pragma unroll
            for (int m = 0; m < 4; ++m)
#pragma unroll
                for (int n = 0; n < 2; ++n) acc[a][b][m][n] = (f32x4){0.f, 0.f, 0.f, 0.f};
    bf16x8 At[4][2], B0[2][2], B1[2][2];
    const char* cA = (const char*)g.A + (size_t)cur.pm * tstep; const char* cB = (const char*)g.Bt + (size_t)cur.pn * tstep;
    S.a_ready(cur);
    PG8_STAGE(PG8_SB(0, 0), cB, voffB); PG8_STAGE(PG8_SA(0, 0), cA, voffA); PG8_STAGE(PG8_SB(0, 1), cB + hstep, voffB); PG8_STAGE(PG8_SA(0, 1), cA + hstep, voffA);
    if (wr == 1) PG8_BAR;
    PG8_WAIT_V(4); PG8_BAR;
    PG8_STAGE(PG8_SB(1, 0), cB + kstep, voffB); PG8_STAGE(PG8_SA(1, 0), cA + kstep, voffA); PG8_STAGE(PG8_SB(1, 1), cB + hstep + kstep, voffB);
    PG8_WAIT_V(6); PG8_BAR;
    PG8_STAMP();
    for (;;) {
        const bool has_next = S.next(ui + 1, nxt);
        const char* nA = has_next ? (const char*)g.A + (size_t)nxt.pm * tstep : cA; const char* nB = has_next ? (const char*)g.Bt + (size_t)nxt.pn * tstep : cB;
        for (int t = 0; t < nt; t += 2) {
            const bool last = (t == nt - 2);
            const char* a1 = cA + (size_t)(t + 1) * kstep;
            const char* a2 = last ? nA : cA + (size_t)(t + 2) * kstep; const char* b2 = last ? nB : cB + (size_t)(t + 2) * kstep;
            const char* a3 = a2 + kstep; const char* b3 = b2 + kstep;
            if (last && has_next) S.a_ready(nxt);
            PG8_LDB(B0, 0, 0); PG8_SCHED; PG8_LDA(At, 0, 0); PG8_STAGE(PG8_SA(1, 1), a1 + hstep, voffA);
            PG8_WAIT_L(8); PG8_BAR; PG8_WAIT_L(0); PG8_MMA(0, 0, At, B0); PG8_BAR; PG8_SCHED;
            PG8_LDB(B1, 0, 1); PG8_STAGE(PG8_SB(0, 0), b2, voffB);
            PG8_BAR; PG8_WAIT_L(0); PG8_MMA(0, 1, At, B1); PG8_BAR;
            PG8_LDA(At, 0, 1); PG8_STAGE(PG8_SA(0, 0), a2, voffA);
            PG8_BAR; PG8_WAIT_L(0); PG8_MMA(1, 0, At, B0); PG8_BAR; PG8_SCHED;
            PG8_STAGE(PG8_SB(0, 1), b2 + hstep, voffB);
            PG8_WAIT_V(6); PG8_BAR; PG8_MMA(1, 1, At, B1); PG8_BAR;
            PG8_LDB(B0, 1, 0); PG8_SCHED; PG8_LDA(At, 1, 0); PG8_STAGE(PG8_SA(0, 1), a2 + hstep, voffA);
            PG8_WAIT_L(8); PG8_BAR; PG8_WAIT_L(0); PG8_MMA(0, 0, At, B0); PG8_BAR; PG8_SCHED;
            PG8_LDB(B1, 1, 1); PG8_STAGE(PG8_SB(1, 0), b3, voffB);
            PG8_BAR; PG8_WAIT_L(0); PG8_MMA(0, 1, At, B1); PG8_BAR;
            PG8_LDA(At, 1, 1); PG8_STAGE(PG8_SA(1, 0), a3, voffA);
            PG8_BAR; PG8_WAIT_L(0); PG8_MMA(1, 0, At, B0); PG8_BAR; PG8_SCHED;
            PG8_STAGE(PG8_SB(1, 1), b3 + hstep, voffB);
            PG8_WAIT_V(6); PG8_BAR; PG8_MMA(1, 1, At, B1); PG8_BAR;
        }
        PG8_STAMP();
        if constexpr (!Epi::AFTER_DRAIN) { E(acc, cur, wr, wc, fr, fq); S.done(cur); }
        PG8_STAMP();
        if (!has_next) break;
#pragma unroll
        for (int a = 0; a < 2; ++a)
#pragma unroll
            for (int b = 0; b < 2; ++b)
#pragma unroll
                for (int m = 0; m < 4; ++m)
#pragma unroll
                    for (int n = 0; n < 2; ++n) acc[a][b][m][n] = (f32x4){0.f, 0.f, 0.f, 0.f};
        cur = nxt; cA = nA; cB = nB; ++ui;
    }
    PG8_WAIT_V(0);
    if (wr == 0) PG8_BAR;
    PG8_BAR;
    if constexpr (Epi::AFTER_DRAIN) { E.fused(acc, cur, wr, wc, fr, fq, lds, wid, lane); S.done(cur); }
    PG8_STAMP();
    if (STAMP && wid == 0) { stamps[lane] = lane < nts ? (((unsigned long long)(unsigned)ts_hi << 32) | (unsigned)ts_lo) : 0ull;
        if (lane == 62) stamps[62] = rt_entry; if (lane == 63) stamps[63] = (unsigned long long)wall_clock64(); }
#undef PG8_STAMP
#undef PG8_SA
#undef PG8_SB
#undef PG8_STAGE
#undef PG8_LDA
#undef PG8_LDB
#undef PG8_MMA
#undef PG8_WAIT_V
#undef PG8_WAIT_L
#undef PG8_BAR
#undef PG8_SCHED
}
}
#define LAS __attribute__((address_space(3)))
typedef unsigned short bf16;
typedef float f32x4 __attribute__((ext_vector_type(4)));
typedef unsigned v4u __attribute__((ext_vector_type(4)));
typedef unsigned v2u __attribute__((ext_vector_type(2)));
constexpr int T = 16384, D = 1024, NP = 2816, FH = 3072, F2 = 6144, DEPTH = 4, NCH = 256  ;
constexpr int C_Q = 0, C_K = 256, C_V = 512, C_G = 1024, C_GATE = 1536, C_LX = 1792, C_LY = 2304;
constexpr int DIN = 2576, O_A = 1536, O_X = 1552;
constexpr float EPS = 1e-6f;
constexpr size_t MiB = 1u << 20;
constexpr size_t WS_WIN = 1 * MiB, WS_WOUT = 7 * MiB, WS_WFI = 9 * MiB, WS_WDN = 21 * MiB, WS_U = 27 * MiB, WS_MIX = 59 * MiB, WS_BIG = 91 * MiB;
constexpr size_t WS_PROJ = WS_BIG, WS_GU = WS_BIG + 88 * MiB, WS_HLOC = WS_GU + 32 * MiB, WS_PCUM = WS_HLOC + 32 * MiB, WS_SMALL = WS_PCUM + 32 * MiB;
constexpr size_t WS_DEC = WS_SMALL, WS_AEND = WS_SMALL + 256 * 1024, WS_HEND = WS_AEND + 512 * 1024, WS_HIN = WS_HEND + 512 * 1024;
constexpr size_t WS_Z = WS_BIG, WS_ACT = WS_BIG + 192 * MiB, WS_END = WS_ACT + 96 * MiB;
constexpr int LDS_BYTES = 147456;

__device__ __forceinline__ unsigned f2bf(float f) { unsigned u = __builtin_bit_cast(unsigned, f); return (u + 0x7fffu + ((u >> 16) & 1u)) >> 16; }
__device__ __forceinline__ unsigned pk2(float lo, float hi) { return f2bf(lo) | (f2bf(hi) << 16); }
__device__ __forceinline__ float bf2f(bf16 b) { return __builtin_bit_cast(float, (unsigned)b << 16); }
__device__ __forceinline__ float bflo(unsigned w) { return __builtin_bit_cast(float, w << 16); }
__device__ __forceinline__ float bfhi(unsigned w) { return __builtin_bit_cast(float, w & 0xffff0000u); }
__device__ __forceinline__ float sigmoidf_(float x) { return 1.0f / (1.0f + __expf(-x)); }
__device__ __forceinline__ float gelu_tanh(float x) { const float y = 0.7978845608028654f * (x + 0.044715f * x * x * x); return x / (1.0f + __expf(-2.0f * y)); }
__device__ __forceinline__ float log_sigmoid(float x) { return fminf(x, 0.0f) - log1pf(__expf(-fabsf(x))); }
__device__ __forceinline__ float wave_sum(float v) {
#pragma unroll
    for (int o = 1; o < 64; o <<= 1) v += __shfl_xor(v, o);
    return v;
}
#define LDS_WAIT() asm volatile("s_waitcnt lgkmcnt(0)" ::: "memory")

struct EpiRes {
    static constexpr bool PERM = false, AFTER_DRAIN = false;
    const float* base; float* out; int ldc;
    __device__ __forceinline__ void operator()(const f32x4 (&acc)[2][2][4][2], const pg8::Unit& u, int wr, int wc, int fr, int fq) const {
        const int row0 = u.pm * 256 + wr * 64 + fr, col0 = u.pn * 256 + wc * 32 + 4 * fq;
#pragma unroll
        for (int ai = 0; ai < 2; ++ai)
#pragma unroll
            for (int m = 0; m < 4; ++m) { const size_t off = (size_t)(row0 + ai * 128 + m * 16) * ldc + col0;
#pragma unroll
                for (int bj = 0; bj < 2; ++bj)
#pragma unroll
                    for (int n = 0; n < 2; ++n) { const size_t o = off + bj * 128 + n * 16; *(f32x4*)(out + o) = *(const f32x4*)(base + o) + acc[ai][bj][m][n]; } }
    }
};

__device__ __forceinline__ void transpose_item(const float* W, int ldw, bf16* WT, int K, LAS float* scr, int kb, int nb, int lane) {
    const int k0 = 64 * kb, n0 = 32 * nb;
#pragma unroll 8
    for (int i = 0; i < 32; ++i) { const int kk = 2 * i + (lane >> 5); scr[kk * 33 + (lane & 31)] = W[(size_t)(k0 + kk) * ldw + n0 + (lane & 31)]; }
    LDS_WAIT();
    const int c = lane & 7;
#pragma unroll
    for (int j = 0; j < 4; ++j) { const int n = (lane >> 3) + 8 * j; const LAS float* s = scr + (8 * c) * 33 + n;
        v4u o; o.x = pk2(s[0 * 33], s[1 * 33]); o.y = pk2(s[2 * 33], s[3 * 33]); o.z = pk2(s[4 * 33], s[5 * 33]); o.w = pk2(s[6 * 33], s[7 * 33]);
        *(v4u*)(WT + (size_t)(n0 + n) * K + k0 + 8 * c) = o; }
    LDS_WAIT();
}

__device__ __forceinline__ void norm_row_bf16(const float* xrow, const float* g, bf16* orow, int lane) {
    const f32x4* xr = (const f32x4*)xrow + lane; const f32x4* gr = (const f32x4*)g + lane;
    f32x4 v[4]; float s = 0.f;
#pragma unroll
    for (int j = 0; j < 4; ++j) { v[j] = xr[64 * j]; s += (v[j].x * v[j].x + v[j].y * v[j].y) + (v[j].z * v[j].z + v[j].w * v[j].w); }
    const float sc = 1.0f / sqrtf(wave_sum(s) * (1.0f / D) + EPS);
    v2u* o8 = (v2u*)orow + lane;
#pragma unroll
    for (int j = 0; j < 4; ++j) { const f32x4 gg = gr[64 * j]; v2u w; w.x = pk2(v[j].x * sc * gg.x, v[j].y * sc * gg.y); w.y = pk2(v[j].z * sc * gg.z, v[j].w * sc * gg.w); o8[64 * j] = w; }
}

struct Args { const float* in[20]; float* out; unsigned char* ws; };
enum { I_X = 0, I_LNMIX, I_WIN, I_W2, I_GB, I_GNORM, I_LCW, I_LCB, I_WA, I_BA, I_WX, I_BX, I_LAM, I_WOUT, I_LNFFN, I_FWIN, I_FCW, I_FCB, I_FWDN, I_LNF };
__global__ void __launch_bounds__(512, 2) trunk_fwd(Args args) {
    extern __shared__ __attribute__((aligned(16))) unsigned char lds_raw[];
    cg::grid_group grid = cg::this_grid();
    LAS unsigned char* lds = (LAS unsigned char*)lds_raw;
    LAS float* ldsf = (LAS float*)lds_raw;
    const int G = gridDim.x, bid = blockIdx.x, NGW = G * 8;
    const size_t NGT = (size_t)G * 512;
#define PHASE_IDS int tid_ = threadIdx.x; asm volatile("" : "+v"(tid_)); const int tid = tid_, lane = tid & 63, wave = __builtin_amdgcn_readfirstlane(tid >> 6), gw = bid * 8 + wave; const size_t gtid = (size_t)bid * 512 + tid; (void)lane; (void)gw; (void)gtid;
    unsigned char* ws = args.ws;
    bf16* Win_t = (bf16*)(ws + WS_WIN); bf16* Wout_t = (bf16*)(ws + WS_WOUT); bf16* Wfi_t = (bf16*)(ws + WS_WFI); bf16* Wdn_t = (bf16*)(ws + WS_WDN);
    bf16* U = (bf16*)(ws + WS_U); bf16* MIX = (bf16*)(ws + WS_MIX); bf16* PROJ = (bf16*)(ws + WS_PROJ); bf16* Z = (bf16*)(ws + WS_Z); bf16* ACT = (bf16*)(ws + WS_ACT);
    float* GU = (float*)(ws + WS_GU); float* HLOC = (float*)(ws + WS_HLOC); float* PCUM = (float*)(ws + WS_PCUM);
    float* DEC = (float*)(ws + WS_DEC); float* AEND = (float*)(ws + WS_AEND); float* HEND = (float*)(ws + WS_HEND); float* HIN = (float*)(ws + WS_HIN);
    const float* X = args.in[I_X]; float* H = args.out;

#pragma unroll 1
    for (int l = 0; l < DEPTH; ++l) {
        const float* hin = (l == 0) ? X : H;
        { PHASE_IDS
            LAS float* scr = ldsf + wave * 4096;
            const float* w_in = args.in[I_WIN] + (size_t)l * D * DIN; const float* w_out = args.in[I_WOUT] + (size_t)l * D * D;
            const float* fwin = args.in[I_FWIN] + (size_t)l * D * F2; const float* fwdn = args.in[I_FWDN] + (size_t)l * FH * D;
            constexpr int I1 = 16 * 48, I2 = 16 * 32, I3 = 16 * 32, I4 = 16 * 192, I5 = 48 * 32, NIT = I1 + I2 + I3 + I4 + I5;
            for (int it = gw; it < NIT; it += NGW) {
                int r = it;
                if (r < I1) { transpose_item(w_in, DIN, Win_t, D, scr, r / 48, r % 48, lane); continue; } r -= I1;
                if (r < I2) { transpose_item(w_in + O_X, DIN, Win_t + (size_t)C_LX * D, D, scr, r / 32, r % 32, lane); continue; } r -= I2;
                if (r < I3) { transpose_item(w_out, D, Wout_t, D, scr, r / 32, r % 32, lane); continue; } r -= I3;
                if (r < I4) { transpose_item(fwin, F2, Wfi_t, D, scr, r / 192, r % 192, lane); continue; } r -= I4;
                transpose_item(fwdn, D, Wdn_t, FH, scr, r / 32, r % 32, lane);
            }
            const float* w2 = args.in[I_W2] + (size_t)l * 16 * 256;
            for (size_t idx = gtid; idx < (size_t)256 * 1024; idx += NGT) { const int j = (int)(idx >> 10), k = (int)(idx & 1023); float a = 0.f;
#pragma unroll
                for (int r = 0; r < 16; ++r) a += w_in[(size_t)k * DIN + O_A + r] * w2[r * 256 + j];
                Win_t[(size_t)(C_GATE + j) * D + k] = (bf16)f2bf(a); }
            const float* g = args.in[I_LNMIX] + l * D;
            for (int m = gw; m < T; m += NGW) norm_row_bf16(hin + (size_t)m * D, g, U + (size_t)m * D, lane);
        }
        grid.sync();
        { pg8::Gemm g{U, Win_t, T, NP, D}; pg8::StaticOrder S; S.init(T, NP, G, bid); pg8::EpiBf16<0> E{PROJ, NP, nullptr, 0, 0};
          pg8::gemm_phase<pg8::EpiBf16<0>, pg8::StaticOrder>(lds, g, S, E, nullptr); }
        grid.sync();
#pragma unroll 1
        for (int n = bid; n < NCH; n += G) { PHASE_IDS
            const int t0 = 64 * n;
            {
                const int c = tid; const float* cw = args.in[I_LCW] + (size_t)l * 4 * 512; const float cb = args.in[I_LCB][l * 512 + c];
                const float cw0 = cw[c], cw1 = cw[512 + c], cw2 = cw[1024 + c], cw3 = cw[1536 + c];
                const bf16* px = PROJ + C_LX + c;
                float xm3 = (t0 >= 3) ? bf2f(px[(size_t)(t0 - 3) * NP]) : 0.f, xm2 = (t0 >= 2) ? bf2f(px[(size_t)(t0 - 2) * NP]) : 0.f, xm1 = (t0 >= 1) ? bf2f(px[(size_t)(t0 - 1) * NP]) : 0.f;
#pragma unroll 8
                for (int tt = 0; tt < 64; ++tt) { const float x0 = bf2f(px[(size_t)(t0 + tt) * NP]); ldsf[tt * 512 + c] = cb + cw0 * xm3 + cw1 * xm2 + cw2 * xm1 + cw3 * x0; xm3 = xm2; xm2 = xm1; xm1 = x0; }
                __syncthreads();
                const int blk = c >> 6, e = c & 63;
                const float* wa = args.in[I_WA] + ((size_t)(l * 8 + blk) * 64) * 64 + e; const float* wx = args.in[I_WX] + ((size_t)(l * 8 + blk) * 64) * 64 + e;
                const float ba = args.in[I_BA][l * 512 + c], bx = args.in[I_BX][l * 512 + c];
                const float lam = args.in[I_LAM][l * 512 + c]; const float sp8 = 8.0f * log1pf(expf(-lam));
                {
                    float war[64];
#pragma unroll
                    for (int d = 0; d < 64; ++d) war[d] = wa[d * 64];
#pragma unroll 1
                    for (int tt = 0; tt < 64; ++tt) { float ra = ba; const LAS float* xr = ldsf + tt * 512 + blk * 64;
#pragma unroll
                        for (int d = 0; d < 64; d += 4) { const f32x4 x4 = *(const LAS f32x4*)(xr + d); ra += x4.x * war[d] + x4.y * war[d + 1] + x4.z * war[d + 2] + x4.w * war[d + 3]; }
                        PCUM[(size_t)(t0 + tt) * 512 + c] = -sp8 * sigmoidf_(ra); }
                }
                float hl = 0.f, pc = 1.f;
                {
                    float wxr[64];
#pragma unroll
                    for (int d = 0; d < 64; ++d) wxr[d] = wx[d * 64];
#pragma unroll 1
                    for (int tt = 0; tt < 64; ++tt) { float ia = bx; const LAS float* xr = ldsf + tt * 512 + blk * 64;
#pragma unroll
                        for (int d = 0; d < 64; d += 4) { const f32x4 x4 = *(const LAS f32x4*)(xr + d); ia += x4.x * wxr[d] + x4.y * wxr[d + 1] + x4.z * wxr[d + 2] + x4.w * wxr[d + 3]; }
                        const float la = PCUM[(size_t)(t0 + tt) * 512 + c]; const float ig = sigmoidf_(ia), a = expf(la);
                        float mult = sqrtf(-expm1f(2.0f * la)); if (t0 + tt == 0) mult = 1.0f;
                        const float uu = mult * (ig * xr[e]);
                        hl = a * hl + uu; pc = pc * a;
                        HLOC[(size_t)(t0 + tt) * 512 + c] = hl; PCUM[(size_t)(t0 + tt) * 512 + c] = pc; }
                }
                AEND[n * 512 + c] = pc; HEND[n * 512 + c] = hl;
                __syncthreads();
            }
            {
                LAS float* bl = ldsf; LAS float* vh = ldsf + 16384;
                if (tid < 256) { const int h = tid >> 6, d = tid & 63; const bf16* pg = PROJ + (size_t)t0 * NP + C_GATE + h * 64 + d; const bf16* pk = PROJ + (size_t)t0 * NP + C_K + h * 64 + d;
                    const float gb = args.in[I_GB][l * 256 + h * 64 + d]; float cum = 0.f;
#pragma unroll 8
                    for (int c = 0; c < 64; ++c) { cum += log_sigmoid(bf2f(pg[(size_t)c * NP]) + gb) * (1.0f / 16.0f); bl[(h * 64 + c) * 64 + d] = cum; }
#pragma unroll 8
                    for (int c = 0; c < 64; ++c) { const float b = bl[(h * 64 + c) * 64 + d]; bl[(h * 64 + c) * 64 + d] = bf2f(pk[(size_t)c * NP]) * __expf(cum - b); }
                    DEC[n * 256 + h * 64 + d] = __expf(cum); }
                __syncthreads();
#pragma unroll 1
                for (int h = 0; h < 4; ++h) {
                    for (int idx = tid; idx < 8192; idx += 512) { const int c = idx >> 7, e = idx & 127; vh[idx] = bf2f(PROJ[(size_t)(t0 + c) * NP + C_V + h * 128 + e]); }
                    __syncthreads();
                    const int dg = tid >> 5, eg = tid & 31; f32x4 acc[4];
#pragma unroll
                    for (int i = 0; i < 4; ++i) acc[i] = (f32x4){0.f, 0.f, 0.f, 0.f};
#pragma unroll 4
                    for (int c = 0; c < 64; ++c) { const f32x4 kd = *(const LAS f32x4*)(bl + (h * 64 + c) * 64 + 4 * dg); const f32x4 v4 = *(const LAS f32x4*)(vh + c * 128 + 4 * eg);
                        acc[0] += kd.x * v4; acc[1] += kd.y * v4; acc[2] += kd.z * v4; acc[3] += kd.w * v4; }
#pragma unroll
                    for (int i = 0; i < 4; ++i) *(f32x4*)(GU + ((size_t)(n * 4 + h) * 64 + 4 * dg + i) * 128 + 4 * eg) = acc[i];
                    __syncthreads();
                }
            }
        }
        grid.sync();
#pragma unroll 1
        for (int it = bid; it < 65; it += G) { PHASE_IDS
            if (it < 64) { const int elem = it * 512 + tid, hd = elem >> 7; float S = 0.f;
#pragma unroll 1
                for (int n0 = 0; n0 < NCH; n0 += 8) { float u[8], dc[8];
#pragma unroll
                    for (int j = 0; j < 8; ++j) { u[j] = GU[(size_t)(n0 + j) * 32768 + elem]; dc[j] = DEC[(n0 + j) * 256 + hd]; }
#pragma unroll
                    for (int j = 0; j < 8; ++j) { GU[(size_t)(n0 + j) * 32768 + elem] = S; S = dc[j] * S + u[j]; } } }
            else { const int c = tid; float hc = 0.f;
#pragma unroll 1
                for (int n0 = 0; n0 < NCH; n0 += 8) { float a[8], b[8];
#pragma unroll
                    for (int j = 0; j < 8; ++j) { a[j] = AEND[(n0 + j) * 512 + c]; b[j] = HEND[(n0 + j) * 512 + c]; }
#pragma unroll
                    for (int j = 0; j < 8; ++j) { HIN[(n0 + j) * 512 + c] = hc; hc = a[j] * hc + b[j]; } } }
        }
        grid.sync();
#pragma unroll 1
        for (int n = bid; n < NCH; n += G) { PHASE_IDS
            const int t0 = 64 * n;
            { const int c = tid; const float hc = HIN[n * 512 + c];
#pragma unroll 4
              for (int tt = 0; tt < 64; ++tt) { const size_t t = t0 + tt; const float hv = HLOC[t * 512 + c] + PCUM[t * 512 + c] * hc; const float gg = bf2f(PROJ[t * NP + C_LY + c]);
                  MIX[t * D + 512 + c] = (bf16)f2bf(hv * gelu_tanh(gg)); } }
            LAS float* bq = ldsf; LAS float* bk = ldsf + 4096; LAS float* Am = ldsf + 8192; LAS float* vh = ldsf + 12288; LAS float* sp = ldsf + 20480;
#pragma unroll 1
            for (int h = 0; h < 4; ++h) {
                for (int idx = tid; idx < 8192; idx += 512) { const int c = idx >> 7, e = idx & 127; vh[idx] = bf2f(PROJ[(size_t)(t0 + c) * NP + C_V + h * 128 + e]); sp[idx] = GU[(size_t)(n * 4 + h) * 8192 + idx]; }
                if (tid < 64) { const int d = tid; const bf16* pg = PROJ + (size_t)t0 * NP + C_GATE + h * 64 + d; const bf16* pq = PROJ + (size_t)t0 * NP + C_Q + h * 64 + d; const bf16* pk = PROJ + (size_t)t0 * NP + C_K + h * 64 + d;
                    const float gb = args.in[I_GB][l * 256 + h * 64 + d]; float cum = 0.f;
#pragma unroll 8
                    for (int c = 0; c < 64; ++c) { cum += log_sigmoid(bf2f(pg[(size_t)c * NP]) + gb) * (1.0f / 16.0f);
                        bq[c * 64 + d] = bf2f(pq[(size_t)c * NP]) * 0.125f * __expf(cum); bk[c * 64 + d] = bf2f(pk[(size_t)c * NP]) * __expf(-cum); } }
                __syncthreads();
                { const int c = tid >> 3, sg = tid & 7; float a8[8];
#pragma unroll
                  for (int j = 0; j < 8; ++j) a8[j] = 0.f;
#pragma unroll 4
                  for (int d = 0; d < 64; d += 4) { const f32x4 q4 = *(const LAS f32x4*)(bq + c * 64 + d);
#pragma unroll
                      for (int j = 0; j < 8; ++j) { const f32x4 k4 = *(const LAS f32x4*)(bk + (8 * sg + j) * 64 + d); a8[j] += q4.x * k4.x + q4.y * k4.y + q4.z * k4.z + q4.w * k4.w; } }
#pragma unroll
                  for (int j = 0; j < 8; ++j) Am[c * 64 + 8 * sg + j] = (8 * sg + j <= c) ? a8[j] : 0.f; }
                __syncthreads();
                { const int c = 8 * wave + (lane >> 3), e0 = 16 * (lane & 7); f32x4 o[4];
#pragma unroll
                  for (int i = 0; i < 4; ++i) o[i] = (f32x4){0.f, 0.f, 0.f, 0.f};
#pragma unroll 4
                  for (int s = 0; s < 64; ++s) { const float a = Am[c * 64 + s]; const LAS f32x4* vr = (const LAS f32x4*)(vh + s * 128 + e0);
#pragma unroll
                      for (int i = 0; i < 4; ++i) o[i] += a * vr[i]; }
#pragma unroll 4
                  for (int d = 0; d < 64; ++d) { const float q = bq[c * 64 + d]; const LAS f32x4* sr = (const LAS f32x4*)(sp + d * 128 + e0);
#pragma unroll
                      for (int i = 0; i < 4; ++i) o[i] += q * sr[i]; }
                  float ss = 0.f;
#pragma unroll
                  for (int i = 0; i < 4; ++i) ss += (o[i].x * o[i].x + o[i].y * o[i].y) + (o[i].z * o[i].z + o[i].w * o[i].w);
                  ss += __shfl_xor(ss, 1); ss += __shfl_xor(ss, 2); ss += __shfl_xor(ss, 4);
                  const float sc = 1.0f / sqrtf(ss * (1.0f / 128.0f) + EPS);
                  const float* gn = args.in[I_GNORM] + l * 128 + e0; const size_t t = t0 + c;
                  const v4u* gp = (const v4u*)(PROJ + t * NP + C_G + h * 128 + e0); v4u* op = (v4u*)(MIX + t * D + h * 128 + e0);
#pragma unroll
                  for (int hh = 0; hh < 2; ++hh) { const v4u gw4 = gp[hh]; const unsigned gwv[4] = {gw4.x, gw4.y, gw4.z, gw4.w}; unsigned ow[4];
#pragma unroll
                      for (int j = 0; j < 4; ++j) { const int i = hh * 2 + (j >> 1); const float v0 = (j & 1) ? o[i].z : o[i].x, v1 = (j & 1) ? o[i].w : o[i].y;
                          const float g0 = bflo(gwv[j]), g1 = bfhi(gwv[j]); const int e = hh * 8 + 2 * j;
                          ow[j] = pk2(v0 * sc * gn[e] * g0 * sigmoidf_(g0), v1 * sc * gn[e + 1] * g1 * sigmoidf_(g1)); }
                      v4u w; w.x = ow[0]; w.y = ow[1]; w.z = ow[2]; w.w = ow[3]; op[hh] = w; } }
                __syncthreads();
            }
        }
        grid.sync();
        { pg8::Gemm g{MIX, Wout_t, T, D, D}; pg8::StaticOrder S; S.init(T, D, G, bid); EpiRes E{hin, H, D};
          pg8::gemm_phase<EpiRes, pg8::StaticOrder>(lds, g, S, E, nullptr); }
        grid.sync();
        { PHASE_IDS const float* g = args.in[I_LNFFN] + l * D; for (int m = gw; m < T; m += NGW) norm_row_bf16(H + (size_t)m * D, g, U + (size_t)m * D, lane); }
        grid.sync();
        { pg8::Gemm g{U, Wfi_t, T, F2, D}; pg8::StaticOrder S; S.init(T, F2, G, bid); pg8::EpiBf16<0> E{Z, F2, nullptr, 0, 0};
          pg8::gemm_phase<pg8::EpiBf16<0>, pg8::StaticOrder>(lds, g, S, E, nullptr); }
        grid.sync();
        { PHASE_IDS
            const float* cw = args.in[I_FCW] + (size_t)l * 3 * F2; const float* cb = args.in[I_FCB] + (size_t)l * F2;
            for (size_t idx = gtid; idx < (size_t)NCH * 384; idx += NGT) { const int n = (int)(idx / 384), cg8 = (int)(idx % 384), t0 = 64 * n, c0 = 8 * cg8;
                float wA[3][8], wG[3][8], bA[8], bG[8];
#pragma unroll
                for (int j = 0; j < 8; ++j) { bA[j] = cb[c0 + j]; bG[j] = cb[FH + c0 + j];
#pragma unroll
                    for (int i = 0; i < 3; ++i) { wA[i][j] = cw[i * F2 + c0 + j]; wG[i][j] = cw[i * F2 + FH + c0 + j]; } }
                v4u a2 = (v4u){0u, 0u, 0u, 0u}, a1 = a2, g2 = a2, g1 = a2;
                if (t0 >= 2) { a2 = *(const v4u*)(Z + (size_t)(t0 - 2) * F2 + c0); g2 = *(const v4u*)(Z + (size_t)(t0 - 2) * F2 + FH + c0); a1 = *(const v4u*)(Z + (size_t)(t0 - 1) * F2 + c0); g1 = *(const v4u*)(Z + (size_t)(t0 - 1) * F2 + FH + c0); }
#pragma unroll 2
                for (int tt = 0; tt < 64; ++tt) { const size_t t = t0 + tt; const v4u a0 = *(const v4u*)(Z + t * F2 + c0), g0 = *(const v4u*)(Z + t * F2 + FH + c0);
                    const unsigned a2w[4] = {a2.x, a2.y, a2.z, a2.w}, a1w[4] = {a1.x, a1.y, a1.z, a1.w}, a0w[4] = {a0.x, a0.y, a0.z, a0.w};
                    const unsigned g2w[4] = {g2.x, g2.y, g2.z, g2.w}, g1w[4] = {g1.x, g1.y, g1.z, g1.w}, g0w[4] = {g0.x, g0.y, g0.z, g0.w}; unsigned ow[4];
#pragma unroll
                    for (int j = 0; j < 4; ++j) {
                        const float za0 = bA[2 * j] + wA[0][2 * j] * bflo(a2w[j]) + wA[1][2 * j] * bflo(a1w[j]) + wA[2][2 * j] * bflo(a0w[j]);
                        const float za1 = bA[2 * j + 1] + wA[0][2 * j + 1] * bfhi(a2w[j]) + wA[1][2 * j + 1] * bfhi(a1w[j]) + wA[2][2 * j + 1] * bfhi(a0w[j]);
                        const float zg0 = bG[2 * j] + wG[0][2 * j] * bflo(g2w[j]) + wG[1][2 * j] * bflo(g1w[j]) + wG[2][2 * j] * bflo(g0w[j]);
                        const float zg1 = bG[2 * j + 1] + wG[0][2 * j + 1] * bfhi(g2w[j]) + wG[1][2 * j + 1] * bfhi(g1w[j]) + wG[2][2 * j + 1] * bfhi(g0w[j]);
                        ow[j] = pk2(gelu_tanh(za0) * zg0, gelu_tanh(za1) * zg1); }
                    v4u w; w.x = ow[0]; w.y = ow[1]; w.z = ow[2]; w.w = ow[3]; *(v4u*)(ACT + t * FH + c0) = w;
                    a2 = a1; a1 = a0; g2 = g1; g1 = g0; }
            }
        }
        grid.sync();
        { pg8::Gemm g{ACT, Wdn_t, T, D, FH}; pg8::StaticOrder S; S.init(T, D, G, bid); EpiRes E{H, H, D};
          pg8::gemm_phase<EpiRes, pg8::StaticOrder>(lds, g, S, E, nullptr); }
        grid.sync();
    }
    { PHASE_IDS const float* g = args.in[I_LNF];
      for (int m = gw; m < T; m += NGW) { f32x4* xr = (f32x4*)(H + (size_t)m * D) + lane; const f32x4* gr = (const f32x4*)g + lane; f32x4 v[4]; float s = 0.f;
#pragma unroll
          for (int j = 0; j < 4; ++j) { v[j] = xr[64 * j]; s += (v[j].x * v[j].x + v[j].y * v[j].y) + (v[j].z * v[j].z + v[j].w * v[j].w); }
          const float sc = 1.0f / sqrtf(wave_sum(s) * (1.0f / D) + EPS);
#pragma unroll
          for (int j = 0; j < 4; ++j) xr[64 * j] = v[j] * sc * gr[64 * j]; } }
}

extern "C" void kernel_launch(void* const* d_in, const int* in_sizes, int n_in, void* d_out, int out_size, void* d_ws, size_t ws_size, hipStream_t stream) {
    static int grid = 0;
    if (grid == 0) {
        if (n_in != 20 || out_size != T * D || ws_size < WS_END) { fprintf(stderr, "kernel_launch: unexpected shapes: n_in %d out %d ws %zu (need %zu)\n", n_in, out_size, ws_size, (size_t)WS_END); grid = -1; return; }
        int dev = 0, cus = 0, per_cu = 0;
        hipGetDevice(&dev); hipDeviceGetAttribute(&cus, hipDeviceAttributeMultiprocessorCount, dev);
        if (hipFuncSetAttribute((const void*)trunk_fwd, hipFuncAttributeMaxDynamicSharedMemorySize, LDS_BYTES) != hipSuccess) { fprintf(stderr, "kernel_launch: hipFuncSetAttribute failed\n"); grid = -1; return; }
        if (hipOccupancyMaxActiveBlocksPerMultiprocessor(&per_cu, (const void*)trunk_fwd, 512, LDS_BYTES) != hipSuccess || per_cu < 1) { fprintf(stderr, "kernel_launch: occupancy query says %d\n", per_cu); per_cu = 1; }
        (void)hipGetLastError();
        grid = cus * per_cu; if (grid > 256) grid = 256;
    }
    if (grid < 0) return;
    Args a{};
    for (int i = 0; i < 20; ++i) a.in[i] = (const float*)d_in[i];
    a.out = (float*)d_out; a.ws = (unsigned char*)d_ws;
    void* kargs[] = {&a};
    hipError_t e = hipLaunchCooperativeKernel((const void*)trunk_fwd, dim3(grid), dim3(512), kargs, LDS_BYTES, stream);
    if (e != hipSuccess) fprintf(stderr, "kernel_launch: cooperative launch failed: %s (grid %d)\n", hipGetErrorString(e), grid);
}
```

```cpp
#include <hip/hip_runtime.h>
#include <hip/hip_cooperative_groups.h>
#include <cstdio>
namespace cg = cooperative_groups;
namespace pg8 {
#define PG8_LAS __attribute__((address_space(3)))
typedef unsigned short bf16_t;
typedef short bf16x8 __attribute__((ext_vector_type(8)));
typedef float f32x4 __attribute__((ext_vector_type(4)));
typedef unsigned u32x4 __attribute__((ext_vector_type(4)));
constexpr int BM = 256, BK = 64, HALF = 128, HTB = HALF * BK * 2  , STAGE_BYTES = 8 * HTB, NXCD = 8, WGM = 8;

__host__ __device__ __forceinline__ int lds_byte(int r, int c) { const int st = (r >> 4) * 2 + (c >> 5), rr = r & 15, cc = c & 31, ob = rr * 64 + cc * 2; return st * 1024 + (ob ^ (((ob >> 9) & 1) << 5)); }
__host__ __device__ __forceinline__ void stage_rc(int b, int& R, int& C) { const int st = b / 1024, sb = b % 1024, swz = sb ^ (((sb >> 9) & 1) << 5); R = (st >> 1) * 16 + swz / 64; C = (st & 1) * 32 + (swz % 64) / 2; }
__host__ __device__ __forceinline__ int perm32(int rho) { const int n = rho >> 4, i = rho & 15; return 8 * (i >> 2) + 4 * n + (i & 3); }

struct Unit { int pm, pn; };
struct Gemm { const bf16_t* A; const bf16_t* Bt; int M, N, K; };

struct StaticOrder {
    int nM, nN, nwg, G, c;
    __host__ __device__ void init(int M, int N, int G_, int c_) { nM = M / BM; nN = N / BM; nwg = nM * nN; G = G_; c = c_; }
    __host__ __device__ bool next(int i, Unit& u) const {
        const long L = (long)i * G + c; if (L >= nwg) return false;
        int wgid = (int)L; { const int q = nwg / NXCD, r = nwg % NXCD, xcd = wgid % NXCD, off = wgid / NXCD; wgid = (xcd < r ? xcd * (q + 1) : r * (q + 1) + (xcd - r) * q) + off; }
        const int nig = WGM * nN, gid = wgid / nig, fm = gid * WGM, gsz = (nM - fm) < WGM ? (nM - fm) : WGM;
        u.pm = fm + ((wgid % nig) % gsz); u.pn = (wgid % nig) / gsz; return true;
    }
    __device__ __forceinline__ void a_ready(const Unit&) const {}
    __device__ __forceinline__ void a_first(const Unit&) const {}
    __device__ __forceinline__ void done(const Unit&) const {}
};
__device__ __forceinline__ unsigned cvt_pk_bf16(float lo, float hi) { unsigned r; asm volatile("v_cvt_pk_bf16_f32 %0, %1, %2" : "=v"(r) : "v"(lo), "v"(hi)); return r; }
typedef float f32x2 __attribute__((ext_vector_type(2)));
__device__ __forceinline__ f32x2 gelu_pk(f32x2 v) {
    const f32x2 av = __builtin_elementwise_abs(v), d = av * 0.2316418882f + 1.0f;
    f32x2 t; t.x = __builtin_amdgcn_rcpf(d.x); t.y = __builtin_amdgcn_rcpf(d.y);
    f32x2 q = t * 0.5307027145f + (-0.7265760135f); q = q * t + 0.7107068705f; q = q * t + (-0.142248368f); q = q * t + 0.127414796f; q = q * t;
    const f32x2 s = (v * v) * (-0.72134752044f);
    f32x2 e; e.x = __builtin_amdgcn_exp2f(s.x); e.y = __builtin_amdgcn_exp2f(s.y);
    const f32x2 m = v * (q * e), r = v - m;
    f32x2 o; o.x = v.x < 0.f ? m.x : r.x; o.y = v.y < 0.f ? m.y : r.y; return o;
}

struct EpiF32 {
    static constexpr bool PERM = false, AFTER_DRAIN = false;
    float* C; int ldc; const float* bias;
    __device__ __forceinline__ void operator()(const f32x4 (&acc)[2][2][4][2], const Unit& u, int wr, int wc, int fr, int fq) const {
        const int row0 = u.pm * BM + wr * 64 + fr, col0 = u.pn * BM + wc * 32 + 4 * fq;
        f32x4 bv[2][2];
#pragma unroll
        for (int bj = 0; bj < 2; ++bj)
#pragma unroll
            for (int n = 0; n < 2; ++n) bv[bj][n] = bias ? *(const f32x4*)(bias + col0 + bj * HALF + n * 16) : (f32x4){0.f, 0.f, 0.f, 0.f};
#pragma unroll
        for (int ai = 0; ai < 2; ++ai)
#pragma unroll
            for (int m = 0; m < 4; ++m) { float* rowp = C + (size_t)(row0 + ai * HALF + m * 16) * ldc + col0;
#pragma unroll
                for (int bj = 0; bj < 2; ++bj)
#pragma unroll
                    for (int n = 0; n < 2; ++n) *(f32x4*)(rowp + bj * HALF + n * 16) = acc[ai][bj][m][n] + bv[bj][n]; }
    }
};
template <int ACT  > struct EpiBf16 {
    static constexpr bool PERM = true, AFTER_DRAIN = false;
    bf16_t* O; int ldc; const float* bias; int split_cols; size_t split_stride;
    __device__ __forceinline__ void operator()(const f32x4 (&acc)[2][2][4][2], const Unit& u, int wr, int wc, int fr, int fq) const {
        const int row0 = u.pm * BM + wr * 64 + fr; int colt = u.pn * BM; bf16_t* base = O;
        if (split_cols) { const int t = colt / split_cols; base += (size_t)t * split_stride; colt -= t * split_cols; }
        const int col0 = colt + wc * 32 + 8 * fq, bcol0 = u.pn * BM + wc * 32 + 8 * fq;
        f32x4 bv[2][2];
#pragma unroll
        for (int bj = 0; bj < 2; ++bj)
#pragma unroll
            for (int n = 0; n < 2; ++n) bv[bj][n] = bias ? *(const f32x4*)(bias + bcol0 + bj * HALF + 4 * n) : (f32x4){0.f, 0.f, 0.f, 0.f};
#pragma unroll
        for (int ai = 0; ai < 2; ++ai)
#pragma unroll
            for (int m = 0; m < 4; ++m) { bf16_t* rowp = base + (size_t)(row0 + ai * HALF + m * 16) * ldc + col0;
#pragma unroll
                for (int bj = 0; bj < 2; ++bj) { f32x4 v0 = acc[ai][bj][m][0] + bv[bj][0], v1 = acc[ai][bj][m][1] + bv[bj][1];
                    if (ACT == 1) { f32x2 a = gelu_pk((f32x2){v0[0], v0[1]}), b = gelu_pk((f32x2){v0[2], v0[3]}), c = gelu_pk((f32x2){v1[0], v1[1]}), d = gelu_pk((f32x2){v1[2], v1[3]});
                        v0 = (f32x4){a.x, a.y, b.x, b.y}; v1 = (f32x4){c.x, c.y, d.x, d.y}; }
                    if (ACT == 2) {
#pragma unroll
                        for (int j = 0; j < 4; ++j) { v0[j] = 0.5f * v0[j] * (1.0f + erff(v0[j] * 0.70710678f)); v1[j] = 0.5f * v1[j] * (1.0f + erff(v1[j] * 0.70710678f)); } }
                    u32x4 w; w.x = cvt_pk_bf16(v0[0], v0[1]); w.y = cvt_pk_bf16(v0[2], v0[3]); w.z = cvt_pk_bf16(v1[0], v1[1]); w.w = cvt_pk_bf16(v1[2], v1[3]);
                    *(u32x4*)(rowp + bj * HALF) = w; } }
    }
};
template <class Epi, class Sched, bool STAMP = false>
__device__ __forceinline__ void gemm_phase(PG8_LAS unsigned char* lds, const Gemm g, const Sched& S, const Epi& E, unsigned long long* stamps) {
    int tid_ = threadIdx.x; asm volatile("" : "+v"(tid_)); const int tid = tid_, wid = __builtin_amdgcn_readfirstlane(tid >> 6), lane = tid & 63, wr = wid >> 2, wc = wid & 3, fr = lane & 15, fq = lane >> 4;
    const int K = g.K, nt = K / BK;
    int ts_lo = 0, ts_hi = 0, nts = 0; const unsigned long long rt_entry = STAMP ? (unsigned long long)wall_clock64() : 0ull;
#define PG8_STAMP() do { if (STAMP && wid == 0 && nts < 64) { const unsigned long long _c = (unsigned long long)clock64(); \
        ts_lo = (lane == nts) ? (int)(unsigned)_c : ts_lo; ts_hi = (lane == nts) ? (int)(unsigned)(_c >> 32) : ts_hi; ++nts; } } while (0)
    PG8_STAMP();
    unsigned voffA[2], voffB[2];
#pragma unroll
    for (int i = 0; i < 2; ++i) { int R, C; stage_rc(tid * 16 + i * 8192, R, C); const int Rb = Epi::PERM ? ((R & ~31) + perm32(R & 31)) : R;
        voffA[i] = (unsigned)(R * K + C) * 2u; voffB[i] = (unsigned)(Rb * K + C) * 2u; }
    const size_t kstep = (size_t)(BK * 2);
    const size_t hstep = (size_t)HALF * K * 2;
    const size_t tstep = 2 * hstep;
    const unsigned ldsw = (unsigned)wid * 1024u;
    const int aoff = lds_byte(wr * 64 + fr, fq * 8), boff = lds_byte(wc * 32 + fr, fq * 8);
#define PG8_SA(b, h) (((b) * 2 + (h)) * HTB)
#define PG8_SB(b, h) ((4 + (b) * 2 + (h)) * HTB)
#define PG8_STAGE(bufoff, gbase, voff) do { _Pragma("unroll") for (int _i = 0; _i < 2; ++_i) \
        __builtin_amdgcn_global_load_lds((const unsigned*)((const char*)(gbase) + (voff)[_i]), (PG8_LAS unsigned*)(lds + (bufoff) + ldsw + _i * 8192), 16, 0, 0); } while (0)
#define PG8_LDA(dst, b, h) do { _Pragma("unroll") for (int m = 0; m < 4; ++m) _Pragma("unroll") for (int k = 0; k < 2; ++k) dst[m][k] = *(const PG8_LAS bf16x8*)(lds + PG8_SA(b, h) + aoff + m * 2048 + k * 1024); } while (0)
#define PG8_LDB(dst, b, h) do { _Pragma("unroll") for (int n = 0; n < 2; ++n) _Pragma("unroll") for (int k = 0; k < 2; ++k) dst[n][k] = *(const PG8_LAS bf16x8*)(lds + PG8_SB(b, h) + boff + n * 2048 + k * 1024); } while (0)
#define PG8_MMA(ai, bj, At, Bt) do { __builtin_amdgcn_s_setprio(1); _Pragma("unroll") for (int m = 0; m < 4; ++m) _Pragma("unroll") for (int n = 0; n < 2; ++n) _Pragma("unroll") for (int k = 0; k < 2; ++k) \
        acc[ai][bj][m][n] = __builtin_amdgcn_mfma_f32_16x16x32_bf16(Bt[n][k], At[m][k], acc[ai][bj][m][n], 0, 0, 0); __builtin_amdgcn_s_setprio(0); } while (0)
#define PG8_WAIT_V(n) asm volatile("s_waitcnt vmcnt(" #n ")" ::: "memory")
#define PG8_WAIT_L(n) asm volatile("s_waitcnt lgkmcnt(" #n ")" ::: "memory")
#define PG8_BAR __builtin_amdgcn_s_barrier()
#define PG8_SCHED __builtin_amdgcn_sched_barrier(0)
    Unit cur, nxt; int ui = 0;
    if (!S.next(0, cur)) return;
    f32x4 acc[2][2][4][2];
    bf16x8 At[4][2], B0[2][2], B1[2][2];
    const char* cA = (const char*)g.A + (size_t)cur.pm * tstep; const char* cB = (const char*)g.Bt + (size_t)cur.pn * tstep;
    S.a_first(cur);
#pragma unroll
    for (int a = 0; a < 2; ++a)
#pragma unroll
        for (int b = 0; b < 2; ++b)
#pragma unroll
            for (int m = 0; m < 4; ++m)
#pragma unroll
                for (int n = 0; n < 2; ++n) acc[a][b][m][n] = (f32x4){0.f, 0.f, 0.f, 0.f};
    PG8_STAGE(PG8_SB(0, 0), cB, voffB); PG8_STAGE(PG8_SA(0, 0), cA, voffA); PG8_STAGE(PG8_SB(0, 1), cB + hstep, voffB); PG8_STAGE(PG8_SA(0, 1), cA + hstep, voffA);
    if (wr == 1) PG8_BAR;
    PG8_WAIT_V(4); PG8_BAR;
    PG8_STAGE(PG8_SB(1, 0), cB + kstep, voffB); PG8_STAGE(PG8_SA(1, 0), cA + kstep, voffA); PG8_STAGE(PG8_SB(1, 1), cB + hstep + kstep, voffB);
    PG8_WAIT_V(6); PG8_BAR;
    PG8_STAMP();
    for (;;) {
        const bool has_next = S.next(ui + 1, nxt);
        const char* nA = has_next ? (const char*)g.A + (size_t)nxt.pm * tstep : cA; const char* nB = has_next ? (const char*)g.Bt + (size_t)nxt.pn * tstep : cB;
        for (int t = 0; t < nt; t += 2) {
            const bool last = (t == nt - 2);
            const char* a1 = cA + (size_t)(t + 1) * kstep;
            const char* a2 = last ? nA : cA + (size_t)(t + 2) * kstep; const char* b2 = last ? nB : cB + (size_t)(t + 2) * kstep;
            const char* a3 = a2 + kstep; const char* b3 = b2 + kstep;
            if (last && has_next) S.a_ready(nxt);
            PG8_LDB(B0, 0, 0); PG8_SCHED; PG8_LDA(At, 0, 0); PG8_STAGE(PG8_SA(1, 1), a1 + hstep, voffA);
            PG8_WAIT_L(8); PG8_BAR; PG8_WAIT_L(0); PG8_MMA(0, 0, At, B0); PG8_BAR; PG8_SCHED;
            PG8_LDB(B1, 0, 1); PG8_STAGE(PG8_SB(0, 0), b2, voffB);
            PG8_BAR; PG8_WAIT_L(0); PG8_MMA(0, 1, At, B1); PG8_BAR;
            PG8_LDA(At, 0, 1); PG8_STAGE(PG8_SA(0, 0), a2, voffA);
            PG8_BAR; PG8_WAIT_L(0); PG8_MMA(1, 0, At, B0); PG8_BAR; PG8_SCHED;
            PG8_STAGE(PG8_SB(0, 1), b2 + hstep, voffB);
            PG8_WAIT_V(6); PG8_BAR; PG8_MMA(1, 1, At, B1); PG8_BAR;
            PG8_LDB(B0, 1, 0); PG8_SCHED; PG8_LDA(At, 1, 0); PG8_STAGE(PG8_SA(0, 1), a2 + hstep, voffA);
            PG8_WAIT_L(8); PG8_BAR; PG8_WAIT_L(0); PG8_MMA(0, 0, At, B0); PG8_BAR; PG8_SCHED;
            PG8_LDB(B1, 1, 1); PG8_STAGE(PG8_SB(1, 0), b3, voffB);
            PG8_BAR; PG8_WAIT_L(0); PG8_MMA(0, 1, At, B1); PG8_BAR;
            PG8_LDA(At, 1, 1); PG8_STAGE(PG8_SA(1, 0), a3, voffA);
            PG8_BAR; PG8_WAIT_L(0); PG8_MMA(1, 0, At, B0); PG8_BAR; PG8_SCHED;
            PG8_STAGE(PG8_SB(1, 1), b3 + hstep, voffB);
            PG8_WAIT_V(6); PG8_BAR; PG8_MMA(1, 1, At, B1); PG8_BAR;
        }
        PG8_STAMP();
        if constexpr (!Epi::AFTER_DRAIN) { E(acc, cur, wr, wc, fr, fq); S.done(cur); }
        PG8_STAMP();
        if (!has_next) break;
#pragma unroll
        for (int a = 0; a < 2; ++a)
#pragma unroll
            for (int b = 0; b < 2; ++b)
#pragma unroll
                for (int m = 0; m < 4; ++m)
#pragma unroll
                    for (int n = 0; n < 2; ++n) acc[a][b][m][n] = (f32x4){0.f, 0.f, 0.f, 0.f};
        cur = nxt; cA = nA; cB = nB; ++ui;
    }
    PG8_WAIT_V(0);
    if (wr == 0) PG8_BAR;
    PG8_BAR;
    if constexpr (Epi::AFTER_DRAIN) { E.fused(acc, cur, wr, wc, fr, fq, lds, wid, lane); S.done(cur); }
    PG8_STAMP();
    if (STAMP && wid == 0) { stamps[lane] = lane < nts ? (((unsigned long long)(unsigned)ts_hi << 32) | (unsigned)ts_lo) : 0ull;
        if (lane == 62) stamps[62] = rt_entry; if (lane == 63) stamps[63] = (unsigned long long)wall_clock64(); }
#undef PG8_STAMP
#undef PG8_SA
#undef PG8_SB
#undef PG8_STAGE
#undef PG8_LDA
#undef PG8_LDB
#undef PG8_MMA
#undef PG8_WAIT_V
#undef PG8_WAIT_L
#undef PG8_BAR
#undef PG8_SCHED
}
}
#define LAS __attribute__((address_space(3)))
typedef unsigned short bf16;
typedef float f32x4 __attribute__((ext_vector_type(4)));
typedef unsigned v4u __attribute__((ext_vector_type(4)));
typedef unsigned v2u __attribute__((ext_vector_type(2)));
typedef short bf16x8 __attribute__((ext_vector_type(8)));
constexpr int T = 16384, D = 1024, NP = 2816, FH = 3072, F2 = 6144, DEPTH = 4, NCH = 256  ;
constexpr int C_Q = 0, C_K = 256, C_V = 512, C_G = 1024, C_GATE = 1536, C_LX = 1792, C_LY = 2304;
constexpr int DIN = 2576, O_A = 1536, O_X = 1552;
constexpr float EPS = 1e-6f;
constexpr size_t MiB = 1u << 20;
constexpr size_t WS_WIN = 1 * MiB, WS_WOUT = 7 * MiB, WS_WFI = 9 * MiB, WS_WDN = 21 * MiB, WS_U = 27 * MiB, WS_MIX = 59 * MiB, WS_BIG = 91 * MiB;
constexpr size_t WS_PROJ = WS_BIG, WS_GU = WS_BIG + 88 * MiB, WS_HLOC = WS_GU + 32 * MiB, WS_PCUM = WS_HLOC + 32 * MiB, WS_SMALL = WS_PCUM + 32 * MiB;
constexpr size_t WS_DEC = WS_SMALL, WS_AEND = WS_SMALL + 256 * 1024, WS_HEND = WS_AEND + 512 * 1024, WS_HIN = WS_HEND + 512 * 1024;
constexpr size_t WS_WAT = WS_SMALL + 1792 * 1024, WS_WXT = WS_WAT + 64 * 1024, WS_SPT = WS_SMALL + 2 * MiB;
constexpr size_t WS_ACT = WS_BIG, WS_ZR = WS_BIG + 96 * MiB, WS_END = WS_SPT + 16 * MiB;
static_assert(WS_ZR + 24 * MiB <= WS_END, "ws map");
constexpr size_t WS_SSA = 296 * MiB, WS_SSB = 297 * MiB, WS_SA = 298 * MiB, WS_SB = WS_SA + 65536;
constexpr int LDS_BYTES = 147456;

__device__ __forceinline__ unsigned f2bf(float f) { unsigned u = __builtin_bit_cast(unsigned, f); return (u + 0x7fffu + ((u >> 16) & 1u)) >> 16; }
__device__ __forceinline__ unsigned pk2(float lo, float hi) { return f2bf(lo) | (f2bf(hi) << 16); }
__device__ __forceinline__ float bf2f(bf16 b) { return __builtin_bit_cast(float, (unsigned)b << 16); }
__device__ __forceinline__ float bflo(unsigned w) { return __builtin_bit_cast(float, w << 16); }
__device__ __forceinline__ float bfhi(unsigned w) { return __builtin_bit_cast(float, w & 0xffff0000u); }
__device__ __forceinline__ float sigmoidf_(float x) { return __builtin_amdgcn_rcpf(1.0f + __builtin_amdgcn_exp2f(-1.4426950408889634f * x)); }
__device__ __forceinline__ float gelu_tanh(float x) { const float y = x * (0.7978845608028654f + 0.035677408136300125f * x * x); return x * __builtin_amdgcn_rcpf(1.0f + __builtin_amdgcn_exp2f(-2.885390081777927f * y)); }
__device__ __forceinline__ float log_sigmoid(float x) { return fminf(x, 0.0f) - 0.6931471805599453f * __builtin_amdgcn_logf(1.0f + __builtin_amdgcn_exp2f(-1.4426950408889634f * fabsf(x))); }
__device__ __forceinline__ float wave_sum(float v) {
#pragma unroll
    for (int o = 1; o < 64; o <<= 1) v += __shfl_xor(v, o);
    return v;
}
#define LDS_WAIT() asm volatile("s_waitcnt lgkmcnt(0)" ::: "memory")

__device__ __forceinline__ float row_ss(const float* ss, int row) { const f32x4* p = (const f32x4*)(ss + (size_t)row * 16); const f32x4 a = (p[0] + p[1]) + (p[2] + p[3]); return (a.x + a.y) + (a.z + a.w); }
struct EpiRes {
    static constexpr bool PERM = true, AFTER_DRAIN = false;
    bf16* h; float* ss;
    __device__ __forceinline__ void operator()(const f32x4 (&acc)[2][2][4][2], const pg8::Unit& u, int wr, int wc, int fr_, int fq_) const {
        int ln_ = threadIdx.x; asm volatile("" : "+v"(ln_)); const int fr = ln_ & 15, fq = (ln_ >> 4) & 3; (void)fr_; (void)fq_;
        const int row0 = u.pm * 256 + wr * 64 + fr, col0 = u.pn * 256 + wc * 32 + 8 * fq;
#pragma unroll
        for (int ai = 0; ai < 2; ++ai) { v4u bv[4][2];
#pragma unroll
            for (int m = 0; m < 4; ++m)
#pragma unroll
                for (int bj = 0; bj < 2; ++bj) bv[m][bj] = *(const v4u*)(h + (size_t)(row0 + ai * 128 + m * 16) * D + col0 + bj * 128);
#pragma unroll
            for (int m = 0; m < 4; ++m) { const int row = row0 + ai * 128 + m * 16; float q = 0.f;
#pragma unroll
                for (int bj = 0; bj < 2; ++bj) { const v4u x = bv[m][bj]; const f32x4 a0 = acc[ai][bj][m][0], a1 = acc[ai][bj][m][1];
                    const float o0 = bflo(x.x) + a0[0], o1 = bfhi(x.x) + a0[1], o2 = bflo(x.y) + a0[2], o3 = bfhi(x.y) + a0[3], o4 = bflo(x.z) + a1[0], o5 = bfhi(x.z) + a1[1], o6 = bflo(x.w) + a1[2], o7 = bfhi(x.w) + a1[3];
                    q += ((o0 * o0 + o1 * o1) + (o2 * o2 + o3 * o3)) + ((o4 * o4 + o5 * o5) + (o6 * o6 + o7 * o7));
                    v4u w; w.x = pg8::cvt_pk_bf16(o0, o1); w.y = pg8::cvt_pk_bf16(o2, o3); w.z = pg8::cvt_pk_bf16(o4, o5); w.w = pg8::cvt_pk_bf16(o6, o7);
                    *(v4u*)(h + (size_t)row * D + col0 + bj * 128) = w; }
                q += __shfl_xor(q, 16); q += __shfl_xor(q, 32);
                if (fq == 0) ss[(size_t)row * 16 + u.pn * 4 + wc] = q; } }
    }
};
struct EpiBf16S {
    static constexpr bool PERM = true, AFTER_DRAIN = false;
    bf16* O; int ldc; const LAS float* tab; mutable int k;
    __device__ __forceinline__ void operator()(const f32x4 (&acc)[2][2][4][2], const pg8::Unit& u, int wr, int wc, int fr_, int fq_) const {
        int ln_ = threadIdx.x; asm volatile("" : "+v"(ln_)); const int fr = ln_ & 15, fq = (ln_ >> 4) & 3; (void)fr_; (void)fq_;
        const int row0 = u.pm * 256 + wr * 64 + fr, col0 = u.pn * 256 + wc * 32 + 8 * fq;
        const LAS float* tb = tab + (k & 1) * 256; ++k;
        float s[2][4];
#pragma unroll
        for (int ai = 0; ai < 2; ++ai)
#pragma unroll
            for (int m = 0; m < 4; ++m) s[ai][m] = tb[wr * 64 + fr + ai * 128 + m * 16];
#pragma unroll
        for (int ai = 0; ai < 2; ++ai)
#pragma unroll
            for (int m = 0; m < 4; ++m) { bf16* rowp = O + (size_t)(row0 + ai * 128 + m * 16) * ldc + col0;
#pragma unroll
                for (int bj = 0; bj < 2; ++bj) { const f32x4 v0 = acc[ai][bj][m][0] * s[ai][m], v1 = acc[ai][bj][m][1] * s[ai][m];
                    v4u w; w.x = pg8::cvt_pk_bf16(v0[0], v0[1]); w.y = pg8::cvt_pk_bf16(v0[2], v0[3]); w.z = pg8::cvt_pk_bf16(v1[0], v1[1]); w.w = pg8::cvt_pk_bf16(v1[2], v1[3]);
                    *(v4u*)(rowp + bj * 128) = w; } }
    }
};

__device__ __forceinline__ float dpp_ror1(float x) { return __builtin_bit_cast(float, __builtin_amdgcn_update_dpp(0, __builtin_bit_cast(int, x), 0x121, 0xf, 0xf, false)); }
__device__ __forceinline__ float dpp_ror2(float x) { return __builtin_bit_cast(float, __builtin_amdgcn_update_dpp(0, __builtin_bit_cast(int, x), 0x122, 0xf, 0xf, false)); }
__device__ __forceinline__ float gelu_fast(float x) { const float y = x * (0.7978845608028654f + 0.035677408136300125f * x * x); return x * __builtin_amdgcn_rcpf(1.0f + __builtin_amdgcn_exp2f(-2.885390081777927f * y)); }

struct EpiFfn {
    static constexpr bool PERM = true, AFTER_DRAIN = false;
    bf16* act; float* zr; const LAS float* tab; mutable int k;
    __device__ __forceinline__ void operator()(const f32x4 (&acc_)[2][2][4][2], const pg8::Unit& u, int wr, int wc, int fr_, int fq_) const {
        int ln_ = threadIdx.x; asm volatile("" : "+v"(ln_)); const int fr = ln_ & 15, fq = (ln_ >> 4) & 3; (void)fr_; (void)fq_;
        f32x4 (&acc)[2][2][4][2] = const_cast<f32x4 (&)[2][2][4][2]>(acc_);
        const bool f0 = (fr == 0), f01 = (fr < 2);
        const LAS float* tb = tab + (k & 1) * 1280; ++k;
        float srow[2][4];
#pragma unroll
        for (int ai = 0; ai < 2; ++ai)
#pragma unroll
            for (int m = 0; m < 4; ++m) srow[ai][m] = tb[1024 + ai * 128 + wr * 64 + m * 16 + fr];
        typedef float f32x2_ __attribute__((ext_vector_type(2)));
        const int jl = wc * 32 + 8 * fq, ch = u.pn * 128 + jl;
        f32x4 wA[2][3], wG[2][3], bA[2], bG[2];
#pragma unroll
        for (int n = 0; n < 2; ++n) {
#pragma unroll
            for (int j = 0; j < 3; ++j) { wA[n][j] = *(const LAS f32x4*)(tb + j * 256 + jl + 4 * n); wG[n][j] = *(const LAS f32x4*)(tb + j * 256 + 128 + jl + 4 * n); }
            bA[n] = *(const LAS f32x4*)(tb + 768 + jl + 4 * n); bG[n] = *(const LAS f32x4*)(tb + 768 + 128 + jl + 4 * n); }
#pragma unroll
        for (int ai = 0; ai < 2; ++ai)
#pragma unroll
            for (int m = 0; m < 4; ++m)
#pragma unroll
                for (int bj = 0; bj < 2; ++bj)
#pragma unroll
                    for (int n = 0; n < 2; ++n) acc[ai][bj][m][n] *= srow[ai][m];
#pragma unroll
        for (int ai = 0; ai < 2; ++ai) { const int gb = u.pm * 4 + ai * 2 + wr;
            if (fr < 2) { float* z = zr + ((size_t)gb * 4 + fr) * F2 + u.pn * 256 + jl; *(f32x4*)z = acc[ai][0][0][0]; *(f32x4*)(z + 4) = acc[ai][0][0][1]; *(f32x4*)(z + 128) = acc[ai][1][0][0]; *(f32x4*)(z + 132) = acc[ai][1][0][1]; }
            if (fr >= 14) { float* z = zr + ((size_t)gb * 4 + (fr - 12)) * F2 + u.pn * 256 + jl; *(f32x4*)z = acc[ai][0][3][0]; *(f32x4*)(z + 4) = acc[ai][0][3][1]; *(f32x4*)(z + 128) = acc[ai][1][3][0]; *(f32x4*)(z + 132) = acc[ai][1][3][1]; }
            unsigned outw[4][2][2];
#pragma unroll
            for (int n = 0; n < 2; ++n)
#pragma unroll
                for (int ip = 0; ip < 2; ++ip) {
                    const f32x2_ wa0 = (f32x2_){wA[n][0][2 * ip], wA[n][0][2 * ip + 1]}, wa1 = (f32x2_){wA[n][1][2 * ip], wA[n][1][2 * ip + 1]}, wa2 = (f32x2_){wA[n][2][2 * ip], wA[n][2][2 * ip + 1]}, ba = (f32x2_){bA[n][2 * ip], bA[n][2 * ip + 1]};
                    const f32x2_ wg0 = (f32x2_){wG[n][0][2 * ip], wG[n][0][2 * ip + 1]}, wg1 = (f32x2_){wG[n][1][2 * ip], wG[n][1][2 * ip + 1]}, wg2 = (f32x2_){wG[n][2][2 * ip], wG[n][2][2 * ip + 1]}, bg = (f32x2_){bG[n][2 * ip], bG[n][2 * ip + 1]};
                    f32x2_ pa1 = (f32x2_){0.f, 0.f}, pa2 = pa1, pg1 = pa1, pg2 = pa1;
#pragma unroll
                    for (int m = 0; m < 4; ++m) { f32x2_ ca, cg, ra1, ra2, rg1, rg2, za, zg;
                        ca.x = acc[ai][0][m][n][2 * ip]; ca.y = acc[ai][0][m][n][2 * ip + 1]; cg.x = acc[ai][1][m][n][2 * ip]; cg.y = acc[ai][1][m][n][2 * ip + 1];
                        ra1.x = dpp_ror1(ca.x); ra1.y = dpp_ror1(ca.y); ra2.x = dpp_ror2(ca.x); ra2.y = dpp_ror2(ca.y); rg1.x = dpp_ror1(cg.x); rg1.y = dpp_ror1(cg.y); rg2.x = dpp_ror2(cg.x); rg2.y = dpp_ror2(cg.y);
                        const f32x2_ a1 = f0 ? pa1 : ra1, a2 = f01 ? pa2 : ra2, g1 = f0 ? pg1 : rg1, g2 = f01 ? pg2 : rg2;
                        za = ba + wa0 * a2 + wa1 * a1 + wa2 * ca; zg = bg + wg0 * g2 + wg1 * g1 + wg2 * cg;
                        pa1 = ra1; pa2 = ra2; pg1 = rg1; pg2 = rg2;
                        outw[m][n][ip] = pg8::cvt_pk_bf16(gelu_fast(za.x) * zg.x, gelu_fast(za.y) * zg.y); } }
#pragma unroll
            for (int m = 0; m < 4; ++m) { v4u w; w.x = outw[m][0][0]; w.y = outw[m][0][1]; w.z = outw[m][1][0]; w.w = outw[m][1][1];
                if (m > 0 || !f01) *(v4u*)(act + (size_t)(u.pm * 256 + ai * 128 + wr * 64 + m * 16 + fr) * FH + ch) = w; }
        }
    }
};


struct ScOrder : pg8::StaticOrder {
    const float* sc; LAS unsigned char* tab; mutable int k;
    __device__ __forceinline__ void a_ready(const pg8::Unit& u) const {
        int t_ = threadIdx.x; asm volatile("" : "+v"(t_));
        if (__builtin_amdgcn_readfirstlane(t_ >> 6) == 0) __builtin_amdgcn_global_load_lds((const unsigned*)(sc + u.pm * 256 + 4 * (t_ & 63)), (LAS unsigned*)(tab + (k & 1) * 1024), 16, 0, 0);
        ++k;
    }
    __device__ __forceinline__ void a_first(const pg8::Unit& u) const { a_ready(u); }
};
struct FfnOrder : pg8::StaticOrder {
    const float* cw; const float* cb; const float* sc; LAS unsigned char* tab; mutable int k;
    __device__ __forceinline__ void a_ready(const pg8::Unit& u) const {
        int t_ = threadIdx.x; asm volatile("" : "+v"(t_));
        const int wid = __builtin_amdgcn_readfirstlane(t_ >> 6), lane = t_ & 63;
        if (wid < 5) { const float* src;
            if (wid < 4) src = ((wid < 3) ? cw + (size_t)wid * F2 : cb) + ((lane < 32) ? u.pn * 128 + 4 * lane : FH + u.pn * 128 + 4 * (lane - 32));
            else src = sc + u.pm * 256 + 4 * lane;
            __builtin_amdgcn_global_load_lds((const unsigned*)src, (LAS unsigned*)(tab + (k & 1) * 5120 + wid * 1024), 16, 0, 0); }
        ++k;
    }
    __device__ __forceinline__ void a_first(const pg8::Unit& u) const { a_ready(u); }
};
struct FixOrder : pg8::StaticOrder {
    bf16* act; const float* zr; const float* cw; const float* cb;
    __device__ __forceinline__ void a_first(const pg8::Unit& u) const {
        int t_ = threadIdx.x; asm volatile("" : "+v"(t_));
        if (t_ < 384) { const int j = 8 * t_, colA = (j >> 7) * 256 + (j & 127);
            f32x4 wa[3][2], wg[3][2], ba[2], bg[2];
#pragma unroll
            for (int hv = 0; hv < 2; ++hv) { ba[hv] = *(const f32x4*)(cb + j + 4 * hv); bg[hv] = *(const f32x4*)(cb + FH + j + 4 * hv);
#pragma unroll
                for (int tp = 0; tp < 3; ++tp) { wa[tp][hv] = *(const f32x4*)(cw + tp * F2 + j + 4 * hv); wg[tp][hv] = *(const f32x4*)(cw + tp * F2 + FH + j + 4 * hv); } }
#pragma unroll 1
            for (int qp = 0; qp < 2; ++qp) { f32x4 z[2][4][2][2];
#pragma unroll
                for (int qq = 0; qq < 2; ++qq) { const int gb = u.pm * 4 + 2 * qp + qq; const float* zc = zr + (size_t)gb * 4 * F2 + colA;
#pragma unroll
                    for (int rw = 0; rw < 4; ++rw) { const float* zrow = zc + (ptrdiff_t)(rw - 2) * F2;
#pragma unroll
                        for (int ag = 0; ag < 2; ++ag)
#pragma unroll
                            for (int hv = 0; hv < 2; ++hv) z[qq][rw][ag][hv] = (rw < 2 && gb == 0) ? (f32x4){0.f, 0.f, 0.f, 0.f} : *(const f32x4*)(zrow + 128 * ag + 4 * hv); } }
#pragma unroll
                for (int qq = 0; qq < 2; ++qq) { const int gb = u.pm * 4 + 2 * qp + qq;
#pragma unroll
                    for (int rr2 = 0; rr2 < 2; ++rr2) { unsigned ow[4];
#pragma unroll
                        for (int hv = 0; hv < 2; ++hv) { const f32x4 za = ba[hv] + wa[0][hv] * z[qq][rr2][0][hv] + wa[1][hv] * z[qq][rr2 + 1][0][hv] + wa[2][hv] * z[qq][rr2 + 2][0][hv];
                            const f32x4 zg = bg[hv] + wg[0][hv] * z[qq][rr2][1][hv] + wg[1][hv] * z[qq][rr2 + 1][1][hv] + wg[2][hv] * z[qq][rr2 + 2][1][hv];
                            ow[2 * hv] = pg8::cvt_pk_bf16(gelu_fast(za[0]) * zg[0], gelu_fast(za[1]) * zg[1]); ow[2 * hv + 1] = pg8::cvt_pk_bf16(gelu_fast(za[2]) * zg[2], gelu_fast(za[3]) * zg[3]); }
                        v4u w; w.x = ow[0]; w.y = ow[1]; w.z = ow[2]; w.w = ow[3]; *(v4u*)(act + (size_t)(64 * gb + rr2) * FH + j) = w; } } } }
        asm volatile("s_waitcnt vmcnt(0)" ::: "memory"); __builtin_amdgcn_s_barrier(); asm volatile("" ::: "memory");
    }
    __device__ __forceinline__ void a_ready(const pg8::Unit& u) const {
        int tl_ = threadIdx.x; asm volatile("" : "+v"(tl_));
        for (int it = tl_; it < 3072; it += 512) { const int j8 = it % 384, rq = it / 384, q = rq >> 1, rr2 = rq & 1, gb = u.pm * 4 + q, j = 8 * j8, colA = (j >> 7) * 256 + (j & 127);
            const float* zc = zr + (size_t)gb * 4 * F2 + colA; const float* zp = zc - 4 * F2;
            const float* r2 = rr2 ? zp + 3 * F2 : zp + 2 * F2; const float* r1 = rr2 ? zc : zp + 3 * F2; const float* r0 = rr2 ? zc + F2 : zc;
            const bool z2 = (gb == 0), z1 = (gb == 0) && (rr2 == 0);
            unsigned ow[4];
#pragma unroll
            for (int hv = 0; hv < 2; ++hv) { const int o = 4 * hv; const f32x4 zz = (f32x4){0.f, 0.f, 0.f, 0.f};
                const f32x4 a2 = z2 ? zz : *(const f32x4*)(r2 + o), a1 = z1 ? zz : *(const f32x4*)(r1 + o), a0 = *(const f32x4*)(r0 + o);
                const f32x4 g2 = z2 ? zz : *(const f32x4*)(r2 + 128 + o), g1 = z1 ? zz : *(const f32x4*)(r1 + 128 + o), g0 = *(const f32x4*)(r0 + 128 + o);
                const f32x4 wa0 = *(const f32x4*)(cw + j + o), wa1 = *(const f32x4*)(cw + F2 + j + o), wa2 = *(const f32x4*)(cw + 2 * F2 + j + o), ba = *(const f32x4*)(cb + j + o);
                const f32x4 wg0 = *(const f32x4*)(cw + FH + j + o), wg1 = *(const f32x4*)(cw + F2 + FH + j + o), wg2 = *(const f32x4*)(cw + 2 * F2 + FH + j + o), bg = *(const f32x4*)(cb + FH + j + o);
                const f32x4 za = ba + wa0 * a2 + wa1 * a1 + wa2 * a0, zg = bg + wg0 * g2 + wg1 * g1 + wg2 * g0;
                ow[2 * hv] = pg8::cvt_pk_bf16(gelu_fast(za[0]) * zg[0], gelu_fast(za[1]) * zg[1]); ow[2 * hv + 1] = pg8::cvt_pk_bf16(gelu_fast(za[2]) * zg[2], gelu_fast(za[3]) * zg[3]); }
            v4u w; w.x = ow[0]; w.y = ow[1]; w.z = ow[2]; w.w = ow[3]; *(v4u*)(act + (size_t)(64 * gb + rr2) * FH + j) = w; }
        asm volatile("s_waitcnt vmcnt(0)" ::: "memory"); __builtin_amdgcn_s_barrier(); asm volatile("" ::: "memory");
    }
};

__device__ __forceinline__ void transpose_item(const float* W, int ldw, bf16* WT, int K, LAS float* scr, int kb, int nb, int lane, const float* gk = nullptr) {
    const int k0 = 64 * kb, n0 = 32 * nb;
    float tv[32]; const float* wp = W + (size_t)(k0 + (lane >> 5)) * ldw + n0 + (lane & 31);
#pragma unroll
    for (int i = 0; i < 32; ++i) { tv[i] = *wp; wp += 2 * ldw; }
#pragma unroll
    for (int i = 0; i < 32; ++i) { const int kk = 2 * i + (lane >> 5); scr[kk * 33 + (lane & 31)] = tv[i] * (gk ? gk[k0 + kk] : 1.0f); }
    LDS_WAIT();
    const int c = lane & 7;
#pragma unroll
    for (int j = 0; j < 4; ++j) { const int n = (lane >> 3) + 8 * j; const LAS float* s = scr + (8 * c) * 33 + n;
        v4u o; o.x = pk2(s[0 * 33], s[1 * 33]); o.y = pk2(s[2 * 33], s[3 * 33]); o.z = pk2(s[4 * 33], s[5 * 33]); o.w = pk2(s[6 * 33], s[7 * 33]);
        *(v4u*)(WT + (size_t)(n0 + n) * K + k0 + 8 * c) = o; }
    LDS_WAIT();
}

__device__ __forceinline__ void norm_row_bf16(const float* xrow, const float* g, bf16* orow, int lane) {
    f32x4 v[2][2]; float s = 0.f;
#pragma unroll
    for (int j = 0; j < 2; ++j)
#pragma unroll
        for (int hv = 0; hv < 2; ++hv) { v[j][hv] = *(const f32x4*)(xrow + 512 * j + 8 * lane + 4 * hv); s += (v[j][hv].x * v[j][hv].x + v[j][hv].y * v[j][hv].y) + (v[j][hv].z * v[j][hv].z + v[j][hv].w * v[j][hv].w); }
    const float sc = 1.0f / sqrtf(wave_sum(s) * (1.0f / D) + EPS);
#pragma unroll
    for (int j = 0; j < 2; ++j) { const f32x4 g0 = *(const f32x4*)(g + 512 * j + 8 * lane), g1 = *(const f32x4*)(g + 512 * j + 8 * lane + 4); v4u w;
        w.x = pk2(v[j][0].x * sc * g0.x, v[j][0].y * sc * g0.y); w.y = pk2(v[j][0].z * sc * g0.z, v[j][0].w * sc * g0.w); w.z = pk2(v[j][1].x * sc * g1.x, v[j][1].y * sc * g1.y); w.w = pk2(v[j][1].z * sc * g1.z, v[j][1].w * sc * g1.w);
        *(v4u*)(orow + 512 * j + 8 * lane) = w; }
}

struct Args { const float* in[20]; float* out; unsigned char* ws; };
enum { I_X = 0, I_LNMIX, I_WIN, I_W2, I_GB, I_GNORM, I_LCW, I_LCB, I_WA, I_BA, I_WX, I_BX, I_LAM, I_WOUT, I_LNFFN, I_FWIN, I_FCW, I_FCB, I_FWDN, I_LNF };
#define XB_TMO      128
#define XB_XCNT(j)  (256  + 64 * (j))
#define XB_XSUB(j)  (1280 + 64 * (j))
#define XB_XGEN(j)  (2304 + 64 * (j))
#define XB_TOP      3328
#define XB_TOPGEN   3392
#define XCD_BAR_WORDS 3456
#define XB_SPIN_CAP (1u << 18)

__device__ __forceinline__ unsigned xb_ld(unsigned* p)              { return __hip_atomic_load(p, __ATOMIC_RELAXED, __HIP_MEMORY_SCOPE_AGENT); }
__device__ __forceinline__ unsigned xb_add(unsigned* p, unsigned v) { return __hip_atomic_fetch_add(p, v, __ATOMIC_RELAXED, __HIP_MEMORY_SCOPE_AGENT); }
__device__ __forceinline__ unsigned xb_xcc_id() { return (unsigned)__builtin_amdgcn_s_getreg((3 << 11) | 20) & 0xFu; }
#define XB_SPIN(cond, bar) do { unsigned _sp = 0; while (cond) { __builtin_amdgcn_s_sleep(1); \
    if ((++_sp & 255u) == 0u) { if (xb_ld(&(bar)[XB_TMO])) break; if (_sp > XB_SPIN_CAP) { atomicAdd(&(bar)[XB_TMO], 1u); break; } } } } while (0)

struct XcdBarrier {
    unsigned* bar; unsigned x;
    volatile LAS unsigned* st;
};

__device__ __forceinline__ XcdBarrier xcd_barrier_post(unsigned* bar, volatile LAS unsigned* st) {
    XcdBarrier b; b.bar = bar; b.x = xb_xcc_id(); b.st = st;
    if (threadIdx.x == 0) (void)xb_add(&bar[XB_XCNT(b.x)], 1u);
    return b;
}
__device__ __forceinline__ void xcd_barrier_complete(unsigned* bar, unsigned x, unsigned& nloc, unsigned& nx) {
    const unsigned G = gridDim.x * gridDim.y * gridDim.z;
    unsigned sum, cnt, mine, sp = 0u;
    for (;;) {
        sum = 0u; cnt = 0u; mine = 0u;
#pragma unroll
        for (unsigned j = 0; j < 16; ++j) { const unsigned c = xb_ld(&bar[XB_XCNT(j)]); sum += c; cnt += (c > 0u) ? 1u : 0u; mine = (j == x) ? c : mine; }
        if (sum == G) break;
        __builtin_amdgcn_s_sleep(1);
        if ((++sp & 255u) == 0u) { if (xb_ld(&bar[XB_TMO])) break; if (sp > XB_SPIN_CAP) { atomicAdd(&bar[XB_TMO], 1u); break; } }
    }
    nloc = mine > 0u ? mine : 1u; nx = cnt > 0u ? cnt : 1u;
}

__device__ __forceinline__ void xcd_barrier(const XcdBarrier& b) {
    asm volatile("s_waitcnt vmcnt(0)" ::: "memory");
    __syncthreads();
    if (threadIdx.x == 0) {
        unsigned* bar = b.bar;
        __builtin_amdgcn_s_waitcnt(0);
        unsigned nloc = b.st[0], nx = b.st[1];
        if (nloc == 0u) { xcd_barrier_complete(bar, b.x, nloc, nx); b.st[0] = nloc; b.st[1] = nx; }
        const unsigned old = xb_add(&bar[XB_XSUB(b.x)], 1u);
        const unsigned gen = old / nloc;
        if (old + 1u == (gen + 1u) * nloc) {
            __builtin_amdgcn_fence(__ATOMIC_RELEASE, "agent");
            asm volatile("s_waitcnt vmcnt(0)" ::: "memory");
            const unsigned og = xb_add(&bar[XB_TOP], 1u);
            const unsigned tg = og / nx;
            if (og + 1u == (tg + 1u) * nx) xb_add(&bar[XB_TOPGEN], 1u);
            else XB_SPIN(xb_ld(&bar[XB_TOPGEN]) == tg, bar);
            __builtin_amdgcn_fence(__ATOMIC_ACQUIRE, "agent");
            xb_add(&bar[XB_XGEN(b.x)], 1u);
            asm volatile("s_waitcnt vmcnt(0)" ::: "memory");
        } else {
            XB_SPIN(xb_ld(&bar[XB_XGEN(b.x)]) == gen, bar);
            __builtin_amdgcn_fence(__ATOMIC_ACQUIRE, "agent");
            asm volatile("s_waitcnt vmcnt(0)" ::: "memory");
        }
    }
    __syncthreads();
}
__global__ void __launch_bounds__(512, 2) trunk_fwd(Args args) {
    extern __shared__ __attribute__((aligned(16))) unsigned char lds_raw[];
    cg::grid_group grid = cg::this_grid();
    LAS unsigned char* lds = (LAS unsigned char*)lds_raw;
    LAS float* ldsf = (LAS float*)lds_raw;
    volatile LAS unsigned* bst = (volatile LAS unsigned*)(lds_raw + LDS_BYTES - 64);
    if (threadIdx.x < 16) bst[threadIdx.x] = 0u;
    __syncthreads();
    const XcdBarrier xbar = xcd_barrier_post((unsigned*)args.ws, bst);
    grid.sync();
#define GSYNC() xcd_barrier(xbar)
    const int G = gridDim.x, bid = blockIdx.x, NGW = G * 8;
    const size_t NGT = (size_t)G * 512;
#ifdef PROBE_A
    unsigned long long tl_ = __builtin_amdgcn_s_memrealtime(), ta_ = 0, tb_ = 0;
#define TICK(k) { const unsigned long long now_ = __builtin_amdgcn_s_memrealtime(); if ((k) == PROBE_A) ta_ += now_ - tl_; if ((k) == PROBE_B) tb_ += now_ - tl_; tl_ = now_; }
#else
#define TICK(k)
#endif
#define PHASE_IDS int tid_ = threadIdx.x; asm volatile("" : "+v"(tid_)); const int tid = tid_, lane = tid & 63, wave = __builtin_amdgcn_readfirstlane(tid >> 6), gw = bid * 8 + wave; const size_t gtid = (size_t)bid * 512 + tid; (void)lane; (void)gw; (void)gtid;
    unsigned char* ws = args.ws;
    bf16* Win_t = (bf16*)(ws + WS_WIN); bf16* Wout_t = (bf16*)(ws + WS_WOUT); bf16* Wfi_t = (bf16*)(ws + WS_WFI); bf16* Wdn_t = (bf16*)(ws + WS_WDN);
    bf16* U = (bf16*)(ws + WS_U); bf16* MIX = (bf16*)(ws + WS_MIX); bf16* PROJ = (bf16*)(ws + WS_PROJ); bf16* ACT = (bf16*)(ws + WS_ACT); float* ZR = (float*)(ws + WS_ZR);
    float* GU = (float*)(ws + WS_GU); unsigned* HP = (unsigned*)(ws + WS_HLOC);
    float* DEC = (float*)(ws + WS_DEC); float* AEND = (float*)(ws + WS_AEND); float* HEND = (float*)(ws + WS_HEND); float* HIN = (float*)(ws + WS_HIN);
    bf16* WAT = (bf16*)(ws + WS_WAT); bf16* WXT = (bf16*)(ws + WS_WXT); bf16* SPT = (bf16*)(ws + WS_SPT);
    float* SSA = (float*)(ws + WS_SSA); float* SSB = (float*)(ws + WS_SSB); float* SA = (float*)(ws + WS_SA); float* SB = (float*)(ws + WS_SB);
    const float* X = args.in[I_X]; float* OUT = args.out;

#pragma unroll 1
    for (int l = 0; l < DEPTH; ++l) {
        { PHASE_IDS
            LAS float* scr = ldsf + wave * 4096;
            const float* w_in = args.in[I_WIN] + (size_t)l * D * DIN; const float* w_out = args.in[I_WOUT] + (size_t)l * D * D;
            const float* fwin = args.in[I_FWIN] + (size_t)l * D * F2; const float* fwdn = args.in[I_FWDN] + (size_t)l * FH * D;
            const float* gmix = args.in[I_LNMIX] + l * D; const float* gffn = args.in[I_LNFFN] + l * D;
            constexpr int I1 = 16 * 48, I2 = 16 * 32, I3 = 16 * 32, I4 = 16 * 192, I5 = 48 * 32, NIT = I1 + I2 + I3 + I4 + I5;
            for (int it = gw; it < NIT; it += NGW) {
                int r = it;
                if (r < I1) { transpose_item(w_in, DIN, Win_t, D, scr, r / 48, r % 48, lane, gmix); continue; } r -= I1;
                if (r < I2) { transpose_item(w_in + O_X, DIN, Win_t + (size_t)C_LX * D, D, scr, r / 32, r % 32, lane, gmix); continue; } r -= I2;
                if (r < I3) { transpose_item(w_out, D, Wout_t, D, scr, r / 32, r % 32, lane); continue; } r -= I3;
                if (r < I4) { const int n0 = 32 * (r % 192), jj = (n0 < FH) ? n0 : n0 - FH, dest = 256 * (jj >> 7) + ((n0 < FH) ? 0 : 128) + (jj & 127); transpose_item(fwin + n0, F2, Wfi_t + (size_t)dest * D, D, scr, r / 192, 0, lane, gffn); continue; } r -= I4;
                transpose_item(fwdn, D, Wdn_t, FH, scr, r / 32, r % 32, lane);
            }
            const float* w2 = args.in[I_W2] + (size_t)l * 16 * 256;
            for (size_t idx = gtid; idx < (size_t)256 * 1024; idx += NGT) { const int j = (int)(idx >> 10), k = (int)(idx & 1023); float a = 0.f;
#pragma unroll
                for (int r = 0; r < 16; ++r) a += w_in[(size_t)k * DIN + O_A + r] * w2[r * 256 + j];
                Win_t[(size_t)(C_GATE + j) * D + k] = (bf16)f2bf(a * gmix[k]); }
            { const float* wa = args.in[I_WA] + (size_t)l * 32768; const float* wx = args.in[I_WX] + (size_t)l * 32768;
              for (size_t idx = gtid; idx < 32768; idx += NGT) { const int blk = (int)(idx >> 12), e = (int)(idx >> 6) & 63, d = (int)idx & 63; WAT[idx] = (bf16)f2bf(wa[(blk * 64 + d) * 64 + e]); WXT[idx] = (bf16)f2bf(wx[(blk * 64 + d) * 64 + e]); } }
            if (l == 0) { for (int m = gw; m < T; m += NGW) {
                const float* xrow = X + (size_t)m * D; bf16* orow = U + (size_t)m * D; float s = 0.f;
#pragma unroll
                for (int j = 0; j < 2; ++j) { const f32x4 v0 = *(const f32x4*)(xrow + 512 * j + 8 * lane), v1 = *(const f32x4*)(xrow + 512 * j + 8 * lane + 4);
                    s += ((v0.x * v0.x + v0.y * v0.y) + (v0.z * v0.z + v0.w * v0.w)) + ((v1.x * v1.x + v1.y * v1.y) + (v1.z * v1.z + v1.w * v1.w));
                    v4u w; w.x = pk2(v0.x, v0.y); w.y = pk2(v0.z, v0.w); w.z = pk2(v1.x, v1.y); w.w = pk2(v1.z, v1.w); *(v4u*)(orow + 512 * j + 8 * lane) = w; }
                s = wave_sum(s); if (lane == 0) SA[m] = __builtin_amdgcn_rsqf(s * (1.0f / D) + EPS); } }
            else for (size_t i = gtid; i < (size_t)T; i += NGT) SA[i] = __builtin_amdgcn_rsqf(row_ss(SSA, (int)i) * (1.0f / D) + EPS);
        }
        GSYNC(); TICK(0)
        { pg8::Gemm g{U, Win_t, T, NP, D}; ScOrder S; S.init(T, NP, G, bid); S.sc = SA; S.tab = lds + 131072; S.k = 0; EpiBf16S E{PROJ, NP, (const LAS float*)(lds + 131072), 0};
          pg8::gemm_phase<EpiBf16S, ScOrder>(lds, g, S, E, nullptr); }
        GSYNC(); TICK(1)
#pragma unroll 1
        for (int nn = bid; nn < NCH; nn += G) { PHASE_IDS const int n = (G == 256) ? (((nn & 7) << 5) | (nn >> 3)) : nn;
            const int t0 = 64 * n, fr = lane & 15, fq = lane >> 4;
            {
                LAS bf16* xcb = (LAS bf16*)lds;
                { const int c0 = 8 * (tid & 63), r0 = 8 * (tid >> 6); const float* cw = args.in[I_LCW] + (size_t)l * 4 * 512 + c0; const float* cbp = args.in[I_LCB] + l * 512 + c0;
                  f32x4 w[4][2], bb[2];
#pragma unroll
                  for (int hv = 0; hv < 2; ++hv) { bb[hv] = *(const f32x4*)(cbp + 4 * hv);
#pragma unroll
                      for (int j = 0; j < 4; ++j) w[j][hv] = *(const f32x4*)(cw + j * 512 + 4 * hv); }
                  v4u xr[11];
#pragma unroll
                  for (int i = 0; i < 11; ++i) { const int t = t0 + r0 - 3 + i; xr[i] = (t >= 0) ? *(const v4u*)(PROJ + (size_t)t * NP + C_LX + c0) : (v4u){0u, 0u, 0u, 0u}; }
#pragma unroll
                  for (int rr = 0; rr < 8; ++rr) { unsigned ow[4];
#pragma unroll
                      for (int p = 0; p < 4; ++p) { float lo = bb[p >> 1][2 * (p & 1)], hi = bb[p >> 1][2 * (p & 1) + 1];
#pragma unroll
                          for (int j = 0; j < 4; ++j) { const unsigned xw = (p == 0) ? xr[rr + j].x : (p == 1) ? xr[rr + j].y : (p == 2) ? xr[rr + j].z : xr[rr + j].w;
                              lo += w[j][p >> 1][2 * (p & 1)] * bflo(xw); hi += w[j][p >> 1][2 * (p & 1) + 1] * bfhi(xw); }
                          ow[p] = pk2(lo, hi); }
                      v4u o; o.x = ow[0]; o.y = ow[1]; o.z = ow[2]; o.w = ow[3]; *(LAS v4u*)(xcb + (r0 + rr) * 520 + c0) = o; } }
                __syncthreads();
                const int blk = wave;
                bf16x8 af[4][2];
#pragma unroll
                for (int mt = 0; mt < 4; ++mt)
#pragma unroll
                    for (int ks = 0; ks < 2; ++ks) af[mt][ks] = *(const LAS bf16x8*)(xcb + (16 * mt + fr) * 520 + blk * 64 + 32 * ks + 8 * fq);
#pragma unroll 1
                for (int nt = 0; nt < 4; ++nt) {
                    const int ch = blk * 64 + 16 * nt + fr;
                    const bf16* wra = WAT + ((size_t)(blk * 64 + 16 * nt + fr)) * 64 + 8 * fq; const bf16* wrx = WXT + ((size_t)(blk * 64 + 16 * nt + fr)) * 64 + 8 * fq;
                    bf16x8 ba_[2], bx_[2];
#pragma unroll
                    for (int ks = 0; ks < 2; ++ks) { ba_[ks] = *(const bf16x8*)(wra + 32 * ks); bx_[ks] = *(const bf16x8*)(wrx + 32 * ks); }
                    const float bia = args.in[I_BA][l * 512 + ch], bix = args.in[I_BX][l * 512 + ch]; const float sp8 = 8.0f * log1pf(expf(-args.in[I_LAM][l * 512 + ch]));
                    float Hc = 0.f, Pc = 1.f;
#pragma unroll
                    for (int mt = 0; mt < 4; ++mt) {
                        f32x4 ar = (f32x4){0.f, 0.f, 0.f, 0.f}, ai = ar;
#pragma unroll
                        for (int ks = 0; ks < 2; ++ks) { ar = __builtin_amdgcn_mfma_f32_16x16x32_bf16(af[mt][ks], ba_[ks], ar, 0, 0, 0); ai = __builtin_amdgcn_mfma_f32_16x16x32_bf16(af[mt][ks], bx_[ks], ai, 0, 0, 0); }
                        float hj[4], pj[4]; float Hs = 0.f, Ps = 1.f;
#pragma unroll
                        for (int j = 0; j < 4; ++j) { const int tt = 16 * mt + 4 * fq + j;
                            const float la = -sp8 * sigmoidf_(ar[j] + bia), a = __builtin_amdgcn_exp2f(1.4426950408889634f * la); float mult = __builtin_amdgcn_sqrtf(fmaxf(1.0f - a * a, 0.0f)); if (t0 + tt == 0) mult = 1.0f;
                            const float uu = mult * (sigmoidf_(ai[j] + bix) * bf2f(xcb[tt * 520 + ch]));
                            Hs = a * Hs + uu; Ps = Ps * a; hj[j] = Hs; pj[j] = Ps; }
                        float Pi = Ps, Hi = Hs;
                        { const float P1 = __shfl(Pi, (lane - 16) & 63), H1 = __shfl(Hi, (lane - 16) & 63); if (fq >= 1) { Hi = Pi * H1 + Hi; Pi = Pi * P1; } }
                        { const float P2 = __shfl(Pi, (lane - 32) & 63), H2 = __shfl(Hi, (lane - 32) & 63); if (fq >= 2) { Hi = Pi * H2 + Hi; Pi = Pi * P2; } }
                        float Pe = __shfl(Pi, (lane - 16) & 63), He = __shfl(Hi, (lane - 16) & 63); if (fq == 0) { Pe = 1.f; He = 0.f; }
                        const float h_in = Pe * Hc + He, p_in = Pc * Pe;
#pragma unroll
                        for (int j = 0; j < 4; ++j) { const size_t t = t0 + 16 * mt + 4 * fq + j; HP[t * 512 + ch] = pk2(hj[j] + pj[j] * h_in, pj[j] * p_in); }
                        const float P3 = __shfl(Pi, fr + 48), H3 = __shfl(Hi, fr + 48);
                        Hc = P3 * Hc + H3; Pc = Pc * P3;
                    }
                    if (fq == 0) { AEND[n * 512 + ch] = Pc; HEND[n * 512 + ch] = Hc; }
                }
                __syncthreads();
            }
            {
                LAS bf16* kdT = (LAS bf16*)lds; LAS bf16* vT = kdT + 4 * 64 * 72; LAS float* exch = (LAS float*)(vT + 4 * 128 * 72);
                { const int hd0 = 8 * (tid & 31), rg = tid >> 5, c0 = 4 * rg;
                  v4u gq[4], kq[4];
#pragma unroll
                  for (int r = 0; r < 4; ++r) { const bf16* pr = PROJ + (size_t)(t0 + c0 + r) * NP + hd0; gq[r] = *(const v4u*)(pr + C_GATE); kq[r] = *(const v4u*)(pr + C_K); }
                  const float* gbp = args.in[I_GB] + l * 256 + hd0; const f32x4 gb0 = *(const f32x4*)gbp, gb1 = *(const f32x4*)(gbp + 4);
                  const float gbv[8] = {gb0.x, gb0.y, gb0.z, gb0.w, gb1.x, gb1.y, gb1.z, gb1.w};
                  float cum[8], bl[4][8];
#pragma unroll
                  for (int i = 0; i < 8; ++i) cum[i] = 0.f;
#pragma unroll
                  for (int r = 0; r < 4; ++r) { const unsigned gw_[4] = {gq[r].x, gq[r].y, gq[r].z, gq[r].w};
#pragma unroll
                      for (int i = 0; i < 8; ++i) { const float x = ((i & 1) ? bfhi(gw_[i >> 1]) : bflo(gw_[i >> 1])) + gbv[i]; cum[i] += log_sigmoid(x) * (1.0f / 16.0f); bl[r][i] = cum[i]; } }
                  *(LAS f32x4*)(exch + rg * 256 + hd0) = (f32x4){cum[0], cum[1], cum[2], cum[3]}; *(LAS f32x4*)(exch + rg * 256 + hd0 + 4) = (f32x4){cum[4], cum[5], cum[6], cum[7]};
                  __syncthreads();
                  float off[8], tot[8];
#pragma unroll
                  for (int i = 0; i < 8; ++i) { off[i] = 0.f; tot[i] = 0.f; }
                  for (int g2 = 0; g2 < 16; ++g2) { const f32x4 a = *(const LAS f32x4*)(exch + g2 * 256 + hd0), b2 = *(const LAS f32x4*)(exch + g2 * 256 + hd0 + 4); const float av[8] = {a.x, a.y, a.z, a.w, b2.x, b2.y, b2.z, b2.w};
#pragma unroll
                      for (int i = 0; i < 8; ++i) { tot[i] += av[i]; if (g2 < rg) off[i] += av[i]; } }
#pragma unroll
                  for (int i = 0; i < 8; ++i) { float kd[4];
#pragma unroll
                      for (int r = 0; r < 4; ++r) { const unsigned kw = (i >> 1) == 0 ? kq[r].x : (i >> 1) == 1 ? kq[r].y : (i >> 1) == 2 ? kq[r].z : kq[r].w; const float kv = (i & 1) ? bfhi(kw) : bflo(kw);
                          kd[r] = kv * __expf(tot[i] - (off[i] + bl[r][i])); }
                      v2u w; w.x = pk2(kd[0], kd[1]); w.y = pk2(kd[2], kd[3]); *(LAS v2u*)(kdT + (hd0 + i) * 72 + c0) = w; }
                  if (rg == 0) { *(f32x4*)(DEC + n * 256 + hd0) = (f32x4){__expf(tot[0]), __expf(tot[1]), __expf(tot[2]), __expf(tot[3])}; *(f32x4*)(DEC + n * 256 + hd0 + 4) = (f32x4){__expf(tot[4]), __expf(tot[5]), __expf(tot[6]), __expf(tot[7])}; } }
#pragma unroll
                for (int it = 0; it < 8; ++it) { const int item = it * 512 + tid, c = item & 63, e8 = item >> 6; const v4u w = *(const v4u*)(PROJ + (size_t)(t0 + c) * NP + C_V + 8 * e8);
                    LAS bf16* dst = vT + (size_t)(8 * e8) * 72 + c;
                    dst[0 * 72] = (bf16)(w.x & 0xffff); dst[1 * 72] = (bf16)(w.x >> 16); dst[2 * 72] = (bf16)(w.y & 0xffff); dst[3 * 72] = (bf16)(w.y >> 16);
                    dst[4 * 72] = (bf16)(w.z & 0xffff); dst[5 * 72] = (bf16)(w.z >> 16); dst[6 * 72] = (bf16)(w.w & 0xffff); dst[7 * 72] = (bf16)(w.w >> 16); }
                __syncthreads();
                { const int h = wave >> 1, eb = 4 * (wave & 1); bf16x8 kf[4][2], vf[4][2];
#pragma unroll
                  for (int i = 0; i < 4; ++i)
#pragma unroll
                      for (int ks = 0; ks < 2; ++ks) { kf[i][ks] = *(const LAS bf16x8*)(kdT + (h * 64 + 16 * i + fr) * 72 + 32 * ks + 8 * fq); vf[i][ks] = *(const LAS bf16x8*)(vT + (h * 128 + 16 * (eb + i) + fr) * 72 + 32 * ks + 8 * fq); }
#pragma unroll
                  for (int dt = 0; dt < 4; ++dt)
#pragma unroll
                      for (int et = 0; et < 4; ++et) { f32x4 acc = (f32x4){0.f, 0.f, 0.f, 0.f};
#pragma unroll
                          for (int ks = 0; ks < 2; ++ks) acc = __builtin_amdgcn_mfma_f32_16x16x32_bf16(kf[dt][ks], vf[et][ks], acc, 0, 0, 0);
                          *(f32x4*)(GU + ((size_t)(n * 4 + h) * 128 + 16 * (eb + et) + fr) * 64 + 16 * dt + 4 * fq) = acc; } }
                __syncthreads();
            }
        }
        GSYNC(); TICK(2)
#pragma unroll 1
        for (int it = bid; it < 256; it += G) { PHASE_IDS
            LAS float* ex = ldsf;
            { const int eg = tid & 31, sg = tid >> 5, el = 128 * it + 4 * eg, hd = ((el >> 13) << 6) | (el & 63), nb = 16 * sg;
              f32x4 u[16], dc[16];
#pragma unroll
              for (int j = 0; j < 16; ++j) { u[j] = *(const f32x4*)(GU + (size_t)(nb + j) * 32768 + el); dc[j] = *(const f32x4*)(DEC + (nb + j) * 256 + hd); }
              f32x4 S = (f32x4){0.f, 0.f, 0.f, 0.f}, P = (f32x4){1.f, 1.f, 1.f, 1.f};
#pragma unroll
              for (int j = 0; j < 16; ++j) { S = dc[j] * S + u[j]; P = P * dc[j]; }
              *(LAS f32x4*)(ex + sg * 128 + 4 * eg) = S; *(LAS f32x4*)(ex + 2048 + sg * 128 + 4 * eg) = P;
              __syncthreads();
              f32x4 Sin = (f32x4){0.f, 0.f, 0.f, 0.f};
              for (int s2 = 0; s2 < sg; ++s2) Sin = *(const LAS f32x4*)(ex + 2048 + s2 * 128 + 4 * eg) * Sin + *(const LAS f32x4*)(ex + s2 * 128 + 4 * eg);
              S = Sin;
#pragma unroll
              for (int j = 0; j < 16; ++j) { v2u w; w.x = pk2(S.x, S.y); w.y = pk2(S.z, S.w); *(v2u*)(SPT + (size_t)(nb + j) * 32768 + el) = w; S = dc[j] * S + u[j]; }
              __syncthreads(); }
            if (it < 8) { const int c = 64 * it + (tid & 63), sg = tid >> 6, nb = 32 * sg; float hc = 0.f, pc = 1.f; float a[32], b[32];
#pragma unroll
                for (int j = 0; j < 32; ++j) { a[j] = AEND[(nb + j) * 512 + c]; b[j] = HEND[(nb + j) * 512 + c]; }
#pragma unroll
                for (int j = 0; j < 32; ++j) { hc = a[j] * hc + b[j]; pc = pc * a[j]; }
                ex[sg * 64 + (tid & 63)] = hc; ex[512 + sg * 64 + (tid & 63)] = pc;
                __syncthreads();
                float hin_ = 0.f;
                for (int s2 = 0; s2 < sg; ++s2) hin_ = ex[512 + s2 * 64 + (tid & 63)] * hin_ + ex[s2 * 64 + (tid & 63)];
                hc = hin_;
#pragma unroll
                for (int j = 0; j < 32; ++j) { HIN[(nb + j) * 512 + c] = hc; hc = a[j] * hc + b[j]; }
                __syncthreads(); }
        }
        GSYNC(); TICK(3)
#pragma unroll 1
        for (int nn = bid; nn < NCH; nn += G) { PHASE_IDS const int n = (G == 256) ? (((nn & 7) << 5) | (nn >> 3)) : nn;
            const int t0 = 64 * n, fr = lane & 15, fq = lane >> 4;
            { const int c0 = 8 * (tid & 63), r0 = 8 * (tid >> 6); const f32x4 hc0 = *(const f32x4*)(HIN + n * 512 + c0), hc1 = *(const f32x4*)(HIN + n * 512 + c0 + 4);
#pragma unroll
              for (int tt = 0; tt < 8; ++tt) { const size_t t = t0 + r0 + tt; const v4u hp0 = *(const v4u*)(HP + t * 512 + c0), hp1 = *(const v4u*)(HP + t * 512 + c0 + 4); const v4u gw4 = *(const v4u*)(PROJ + t * NP + C_LY + c0);
                  const f32x4 hv0 = (f32x4){bflo(hp0.x), bflo(hp0.y), bflo(hp0.z), bflo(hp0.w)} + (f32x4){bfhi(hp0.x), bfhi(hp0.y), bfhi(hp0.z), bfhi(hp0.w)} * hc0;
                  const f32x4 hv1 = (f32x4){bflo(hp1.x), bflo(hp1.y), bflo(hp1.z), bflo(hp1.w)} + (f32x4){bfhi(hp1.x), bfhi(hp1.y), bfhi(hp1.z), bfhi(hp1.w)} * hc1;
                  v4u w; w.x = pk2(hv0.x * gelu_tanh(bflo(gw4.x)), hv0.y * gelu_tanh(bfhi(gw4.x))); w.y = pk2(hv0.z * gelu_tanh(bflo(gw4.y)), hv0.w * gelu_tanh(bfhi(gw4.y)));
                  w.z = pk2(hv1.x * gelu_tanh(bflo(gw4.z)), hv1.y * gelu_tanh(bfhi(gw4.z))); w.w = pk2(hv1.z * gelu_tanh(bflo(gw4.w)), hv1.w * gelu_tanh(bfhi(gw4.w)));
                  *(v4u*)(MIX + t * D + 512 + c0) = w; } }
            LAS bf16* qi = (LAS bf16*)lds; LAS bf16* ki = qi + 4 * 64 * 72; LAS bf16* vT = ki + 4 * 64 * 72; LAS bf16* As = vT + 2 * 128 * 72; LAS float* exch = (LAS float*)(As + 8 * 16 * 72);
            { const int hd0 = 8 * (tid & 31), rg = tid >> 5, c0 = 4 * rg, h = hd0 >> 6, d0 = hd0 & 63;
              v4u gq[4], qq[4], kq[4];
#pragma unroll
              for (int r = 0; r < 4; ++r) { const bf16* pr = PROJ + (size_t)(t0 + c0 + r) * NP + hd0; gq[r] = *(const v4u*)(pr + C_GATE); qq[r] = *(const v4u*)(pr + C_Q); kq[r] = *(const v4u*)(pr + C_K); }
              const float* gbp = args.in[I_GB] + l * 256 + hd0; const f32x4 gb0 = *(const f32x4*)gbp, gb1 = *(const f32x4*)(gbp + 4);
              const float gbv[8] = {gb0.x, gb0.y, gb0.z, gb0.w, gb1.x, gb1.y, gb1.z, gb1.w};
              float cum[8], bl[4][8];
#pragma unroll
              for (int i = 0; i < 8; ++i) cum[i] = 0.f;
#pragma unroll
              for (int r = 0; r < 4; ++r) { const unsigned gw_[4] = {gq[r].x, gq[r].y, gq[r].z, gq[r].w};
#pragma unroll
                  for (int i = 0; i < 8; ++i) { const float x = ((i & 1) ? bfhi(gw_[i >> 1]) : bflo(gw_[i >> 1])) + gbv[i]; cum[i] += log_sigmoid(x) * (1.0f / 16.0f); bl[r][i] = cum[i]; } }
              *(LAS f32x4*)(exch + rg * 256 + hd0) = (f32x4){cum[0], cum[1], cum[2], cum[3]}; *(LAS f32x4*)(exch + rg * 256 + hd0 + 4) = (f32x4){cum[4], cum[5], cum[6], cum[7]};
              __syncthreads();
              float off[8];
#pragma unroll
              for (int i = 0; i < 8; ++i) off[i] = 0.f;
              for (int g2 = 0; g2 < rg; ++g2) { const f32x4 a = *(const LAS f32x4*)(exch + g2 * 256 + hd0), b2 = *(const LAS f32x4*)(exch + g2 * 256 + hd0 + 4);
                  off[0] += a.x; off[1] += a.y; off[2] += a.z; off[3] += a.w; off[4] += b2.x; off[5] += b2.y; off[6] += b2.z; off[7] += b2.w; }
#pragma unroll
              for (int r = 0; r < 4; ++r) { const unsigned qw_[4] = {qq[r].x, qq[r].y, qq[r].z, qq[r].w}, kw_[4] = {kq[r].x, kq[r].y, kq[r].z, kq[r].w}; unsigned oq[4], ok[4];
#pragma unroll
                  for (int i2 = 0; i2 < 4; ++i2) { const float b0 = off[2 * i2] + bl[r][2 * i2], b1 = off[2 * i2 + 1] + bl[r][2 * i2 + 1];
                      oq[i2] = pk2(bflo(qw_[i2]) * 0.125f * __expf(b0), bfhi(qw_[i2]) * 0.125f * __expf(b1)); ok[i2] = pk2(bflo(kw_[i2]) * __expf(-b0), bfhi(kw_[i2]) * __expf(-b1)); }
                  *(LAS v4u*)(qi + (h * 64 + c0 + r) * 72 + d0) = (v4u){oq[0], oq[1], oq[2], oq[3]}; *(LAS v4u*)(ki + (h * 64 + c0 + r) * 72 + d0) = (v4u){ok[0], ok[1], ok[2], ok[3]}; } }
#pragma unroll 1
            for (int p = 0; p < 2; ++p) {
#pragma unroll
                for (int it = 0; it < 4; ++it) { const int item = it * 512 + tid, c = item & 63, e8 = item >> 6; const v4u w = *(const v4u*)(PROJ + (size_t)(t0 + c) * NP + C_V + 256 * p + 8 * e8);
                    LAS bf16* dst = vT + (size_t)(8 * e8) * 72 + c;
                    dst[0 * 72] = (bf16)(w.x & 0xffff); dst[1 * 72] = (bf16)(w.x >> 16); dst[2 * 72] = (bf16)(w.y & 0xffff); dst[3 * 72] = (bf16)(w.y >> 16);
                    dst[4 * 72] = (bf16)(w.z & 0xffff); dst[5 * 72] = (bf16)(w.z >> 16); dst[6 * 72] = (bf16)(w.w & 0xffff); dst[7 * 72] = (bf16)(w.w >> 16); }
                __syncthreads();
                { const int hh = wave >> 2, h = 2 * p + hh, ct = wave & 3; LAS bf16* Aw = As + wave * 16 * 72;
                  bf16x8 qf[2];
#pragma unroll
                  for (int ks = 0; ks < 2; ++ks) qf[ks] = *(const LAS bf16x8*)(qi + (h * 64 + 16 * ct + fr) * 72 + 32 * ks + 8 * fq);
#pragma unroll
                  for (int st = 0; st < 4; ++st) { f32x4 dacc = (f32x4){0.f, 0.f, 0.f, 0.f};
                      if (st <= ct) {
#pragma unroll
                          for (int ks = 0; ks < 2; ++ks) { const bf16x8 kf = *(const LAS bf16x8*)(ki + (h * 64 + 16 * st + fr) * 72 + 32 * ks + 8 * fq); dacc = __builtin_amdgcn_mfma_f32_16x16x32_bf16(kf, qf[ks], dacc, 0, 0, 0); }
                          if (st == ct) {
#pragma unroll
                              for (int j = 0; j < 4; ++j) if (4 * fq + j > fr) dacc[j] = 0.f; } }
                      v2u w; w.x = pk2(dacc[0], dacc[1]); w.y = pk2(dacc[2], dacc[3]); *(LAS v2u*)(Aw + fr * 72 + 16 * st + 4 * fq) = w; }
                  bf16x8 afr[2];
#pragma unroll
                  for (int ks = 0; ks < 2; ++ks) afr[ks] = *(const LAS bf16x8*)(Aw + fr * 72 + 32 * ks + 8 * fq);
                  f32x4 o[8]; float ss = 0.f;
                  const int erow = 8 * (fr >> 2) + (fr & 3);
                  const bf16* sp = SPT + ((size_t)(n * 4 + h) * 128 + erow) * 64 + 8 * fq;
#pragma unroll
                  for (int et = 0; et < 8; ++et) { f32x4 acc = (f32x4){0.f, 0.f, 0.f, 0.f};
#pragma unroll
                      for (int ks = 0; ks < 2; ++ks) { const bf16x8 vf = *(const LAS bf16x8*)(vT + (hh * 128 + erow + 32 * (et >> 1) + 4 * (et & 1)) * 72 + 32 * ks + 8 * fq); acc = __builtin_amdgcn_mfma_f32_16x16x32_bf16(vf, afr[ks], acc, 0, 0, 0); }
#pragma unroll
                      for (int ks = 0; ks < 2; ++ks) { const bf16x8 sf = *(const bf16x8*)(sp + (size_t)(32 * (et >> 1) + 4 * (et & 1)) * 64 + 32 * ks); acc = __builtin_amdgcn_mfma_f32_16x16x32_bf16(sf, qf[ks], acc, 0, 0, 0); }
                      o[et] = acc; ss += (acc[0] * acc[0] + acc[1] * acc[1]) + (acc[2] * acc[2] + acc[3] * acc[3]); }
                  ss += __shfl_xor(ss, 16); ss += __shfl_xor(ss, 32);
                  const float sc = 1.0f / sqrtf(ss * (1.0f / 128.0f) + EPS);
                  const size_t t = t0 + 16 * ct + fr; const float* gn = args.in[I_GNORM] + l * 128;
#pragma unroll
                  for (int ep = 0; ep < 4; ++ep) { const int e = 32 * ep + 8 * fq; const v4u gw4 = *(const v4u*)(PROJ + t * NP + C_G + h * 128 + e); const f32x4 ga = *(const f32x4*)(gn + e), gb4 = *(const f32x4*)(gn + e + 4);
                      const f32x4 oa = o[2 * ep], ob = o[2 * ep + 1];
                      const float g0 = bflo(gw4.x), g1 = bfhi(gw4.x), g2 = bflo(gw4.y), g3 = bfhi(gw4.y), g4 = bflo(gw4.z), g5 = bfhi(gw4.z), g6 = bflo(gw4.w), g7 = bfhi(gw4.w);
                      v4u w; w.x = pk2(oa[0] * sc * ga.x * g0 * sigmoidf_(g0), oa[1] * sc * ga.y * g1 * sigmoidf_(g1)); w.y = pk2(oa[2] * sc * ga.z * g2 * sigmoidf_(g2), oa[3] * sc * ga.w * g3 * sigmoidf_(g3));
                      w.z = pk2(ob[0] * sc * gb4.x * g4 * sigmoidf_(g4), ob[1] * sc * gb4.y * g5 * sigmoidf_(g5)); w.w = pk2(ob[2] * sc * gb4.z * g6 * sigmoidf_(g6), ob[3] * sc * gb4.w * g7 * sigmoidf_(g7));
                      *(v4u*)(MIX + t * D + h * 128 + e) = w; } }
                __syncthreads();
            }
        }
        GSYNC(); TICK(4)
        { pg8::Gemm g{MIX, Wout_t, T, D, D}; pg8::StaticOrder S; S.init(T, D, G, bid); EpiRes E{U, SSB};
          pg8::gemm_phase<EpiRes, pg8::StaticOrder>(lds, g, S, E, nullptr); }
        GSYNC(); TICK(5)
        { PHASE_IDS for (size_t i = gtid; i < (size_t)T; i += NGT) SB[i] = __builtin_amdgcn_rsqf(row_ss(SSB, (int)i) * (1.0f / D) + EPS); }
        GSYNC(); TICK(6)
        { pg8::Gemm g{U, Wfi_t, T, F2, D}; FfnOrder S; S.init(T, F2, G, bid); S.cw = args.in[I_FCW] + (size_t)l * 3 * F2; S.cb = args.in[I_FCB] + (size_t)l * F2; S.sc = SB; S.tab = lds + 131072; S.k = 0;
          EpiFfn E{ACT, ZR, (const LAS float*)(lds + 131072), 0};
          pg8::gemm_phase<EpiFfn, FfnOrder>(lds, g, S, E, nullptr); }
        GSYNC(); TICK(7)
        { pg8::Gemm g{ACT, Wdn_t, T, D, FH}; FixOrder S; S.init(T, D, G, bid); S.act = ACT; S.zr = ZR; S.cw = args.in[I_FCW] + (size_t)l * 3 * F2; S.cb = args.in[I_FCB] + (size_t)l * F2; EpiRes E{U, SSA};
          pg8::gemm_phase<EpiRes, FixOrder>(lds, g, S, E, nullptr); }
        GSYNC(); TICK(9)
#ifdef PROBE_A
        GSYNC(); TICK(10)
#endif
    }
    { PHASE_IDS const float* g = args.in[I_LNF];
      for (int m = gw; m < T; m += NGW) { const float sc = __builtin_amdgcn_rsqf(row_ss(SSA, m) * (1.0f / D) + EPS); const bf16* hr = U + (size_t)m * D; float* orow = OUT + (size_t)m * D;
#pragma unroll
          for (int j = 0; j < 2; ++j) { const v4u x = *(const v4u*)(hr + 512 * j + 8 * lane); const f32x4 g0 = *(const f32x4*)(g + 512 * j + 8 * lane), g1 = *(const f32x4*)(g + 512 * j + 8 * lane + 4);
              *(f32x4*)(orow + 512 * j + 8 * lane) = (f32x4){bflo(x.x), bfhi(x.x), bflo(x.y), bfhi(x.y)} * sc * g0; *(f32x4*)(orow + 512 * j + 8 * lane + 4) = (f32x4){bflo(x.z), bfhi(x.z), bflo(x.w), bfhi(x.w)} * sc * g1; } } }
#ifdef PROBE_A
    GSYNC(); TICK(11)
    if (blockIdx.x == 0) { const float va = (float)ta_ * 0.01f, vb = (float)tb_ * 0.01f;
        if (threadIdx.x == 0) OUT[0] += va * 0.004f + vb * 0.0f; }
#endif
}

extern "C" void kernel_launch(void* const* d_in, const int* in_sizes, int n_in, void* d_out, int out_size, void* d_ws, size_t ws_size, hipStream_t stream) {
    static int grid = 0;
    if (grid == 0) {
        if (n_in != 20 || out_size != T * D || ws_size < 299 * MiB) { fprintf(stderr, "kernel_launch: unexpected shapes: n_in %d out %d ws %zu (need %zu)\n", n_in, out_size, ws_size, (size_t)WS_END); grid = -1; return; }
        int dev = 0, cus = 0, per_cu = 0;
        hipGetDevice(&dev); hipDeviceGetAttribute(&cus, hipDeviceAttributeMultiprocessorCount, dev);
        if (hipFuncSetAttribute((const void*)trunk_fwd, hipFuncAttributeMaxDynamicSharedMemorySize, LDS_BYTES) != hipSuccess) { fprintf(stderr, "kernel_launch: hipFuncSetAttribute failed\n"); grid = -1; return; }
        if (hipOccupancyMaxActiveBlocksPerMultiprocessor(&per_cu, (const void*)trunk_fwd, 512, LDS_BYTES) != hipSuccess || per_cu < 1) { fprintf(stderr, "kernel_launch: occupancy query says %d\n", per_cu); per_cu = 1; }
        (void)hipGetLastError();
        grid = cus * per_cu; if (grid > 256) grid = 256;
    }
    if (grid < 0) return;
    if (hipMemsetAsync(d_ws, 0, 65536, stream) != hipSuccess) { fprintf(stderr, "kernel_launch: memset failed\n"); return; }
    Args a{};
    for (int i = 0; i < 20; ++i) a.in[i] = (const float*)d_in[i];
    a.out = (float*)d_out; a.ws = (unsigned char*)d_ws;
    void* kargs[] = {&a};
    hipError_t e = hipLaunchCooperativeKernel((const void*)trunk_fwd, dim3(grid), dim3(512), kargs, LDS_BYTES, stream);
    if (e != hipSuccess) fprintf(stderr, "kernel_launch: cooperative launch failed: %s (grid %d)\n", hipGetErrorString(e), grid);
}
```

```cpp
#include <hip/hip_runtime.h>
#include <hip/hip_cooperative_groups.h>
#include <cstdio>
namespace cg = cooperative_groups;
namespace pg8 {
#define PG8_LAS __attribute__((address_space(3)))
typedef unsigned short bf16_t;
typedef short bf16x8 __attribute__((ext_vector_type(8)));
typedef float f32x4 __attribute__((ext_vector_type(4)));
typedef unsigned u32x4 __attribute__((ext_vector_type(4)));
constexpr int BM = 256, BK = 64, HALF = 128, HTB = HALF * BK * 2  , STAGE_BYTES = 8 * HTB, NXCD = 8, WGM = 8;

__host__ __device__ __forceinline__ int lds_byte(int r, int c) { const int st = (r >> 4) * 2 + (c >> 5), rr = r & 15, cc = c & 31, ob = rr * 64 + cc * 2; return st * 1024 + (ob ^ (((ob >> 9) & 1) << 5)); }
__host__ __device__ __forceinline__ void stage_rc(int b, int& R, int& C) { const int st = b / 1024, sb = b % 1024, swz = sb ^ (((sb >> 9) & 1) << 5); R = (st >> 1) * 16 + swz / 64; C = (st & 1) * 32 + (swz % 64) / 2; }
__host__ __device__ __forceinline__ int perm32(int rho) { const int n = rho >> 4, i = rho & 15; return 8 * (i >> 2) + 4 * n + (i & 3); }

struct Unit { int pm, pn; };
struct Gemm { const bf16_t* A; const bf16_t* Bt; int M, N, K; };

struct StaticOrder {
    int nM, nN, nwg, G, c;
    __host__ __device__ void init(int M, int N, int G_, int c_) { nM = M / BM; nN = N / BM; nwg = nM * nN; G = G_; c = c_; }
    __host__ __device__ bool next(int i, Unit& u) const {
        const long L = (long)i * G + c; if (L >= nwg) return false;
        int wgid = (int)L; { const int q = nwg / NXCD, r = nwg % NXCD, xcd = wgid % NXCD, off = wgid / NXCD; wgid = (xcd < r ? xcd * (q + 1) : r * (q + 1) + (xcd - r) * q) + off; }
        const int nig = WGM * nN, gid = wgid / nig, fm = gid * WGM, gsz = (nM - fm) < WGM ? (nM - fm) : WGM;
        u.pm = fm + ((wgid % nig) % gsz); u.pn = (wgid % nig) / gsz; return true;
    }
    __device__ __forceinline__ void a_ready(const Unit&) const {}
    __device__ __forceinline__ void a_first(const Unit&) const {}
    __device__ __forceinline__ void done(const Unit&) const {}
};
__device__ __forceinline__ unsigned cvt_pk_bf16(float lo, float hi) { unsigned r; asm volatile("v_cvt_pk_bf16_f32 %0, %1, %2" : "=v"(r) : "v"(lo), "v"(hi)); return r; }
typedef float f32x2 __attribute__((ext_vector_type(2)));
__device__ __forceinline__ f32x2 gelu_pk(f32x2 v) {
    const f32x2 av = __builtin_elementwise_abs(v), d = av * 0.2316418882f + 1.0f;
    f32x2 t; t.x = __builtin_amdgcn_rcpf(d.x); t.y = __builtin_amdgcn_rcpf(d.y);
    f32x2 q = t * 0.5307027145f + (-0.7265760135f); q = q * t + 0.7107068705f; q = q * t + (-0.142248368f); q = q * t + 0.127414796f; q = q * t;
    const f32x2 s = (v * v) * (-0.72134752044f);
    f32x2 e; e.x = __builtin_amdgcn_exp2f(s.x); e.y = __builtin_amdgcn_exp2f(s.y);
    const f32x2 m = v * (q * e), r = v - m;
    f32x2 o; o.x = v.x < 0.f ? m.x : r.x; o.y = v.y < 0.f ? m.y : r.y; return o;
}

struct EpiF32 {
    static constexpr bool PERM = false, AFTER_DRAIN = false;
    float* C; int ldc; const float* bias;
    __device__ __forceinline__ void operator()(const f32x4 (&acc)[2][2][4][2], const Unit& u, int wr, int wc, int fr, int fq) const {
        const int row0 = u.pm * BM + wr * 64 + fr, col0 = u.pn * BM + wc * 32 + 4 * fq;
        f32x4 bv[2][2];
#pragma unroll
        for (int bj = 0; bj < 2; ++bj)
#pragma unroll
            for (int n = 0; n < 2; ++n) bv[bj][n] = bias ? *(const f32x4*)(bias + col0 + bj * HALF + n * 16) : (f32x4){0.f, 0.f, 0.f, 0.f};
#pragma unroll
        for (int ai = 0; ai < 2; ++ai)
#pragma unroll
            for (int m = 0; m < 4; ++m) { float* rowp = C + (size_t)(row0 + ai * HALF + m * 16) * ldc + col0;
#pragma unroll
                for (int bj = 0; bj < 2; ++bj)
#pragma unroll
                    for (int n = 0; n < 2; ++n) *(f32x4*)(rowp + bj * HALF + n * 16) = acc[ai][bj][m][n] + bv[bj][n]; }
    }
};
template <int ACT  > struct EpiBf16 {
    static constexpr bool PERM = true, AFTER_DRAIN = false;
    bf16_t* O; int ldc; const float* bias; int split_cols; size_t split_stride;
    __device__ __forceinline__ void operator()(const f32x4 (&acc)[2][2][4][2], const Unit& u, int wr, int wc, int fr, int fq) const {
        const int row0 = u.pm * BM + wr * 64 + fr; int colt = u.pn * BM; bf16_t* base = O;
        if (split_cols) { const int t = colt / split_cols; base += (size_t)t * split_stride; colt -= t * split_cols; }
        const int col0 = colt + wc * 32 + 8 * fq, bcol0 = u.pn * BM + wc * 32 + 8 * fq;
        f32x4 bv[2][2];
#pragma unroll
        for (int bj = 0; bj < 2; ++bj)
#pragma unroll
            for (int n = 0; n < 2; ++n) bv[bj][n] = bias ? *(const f32x4*)(bias + bcol0 + bj * HALF + 4 * n) : (f32x4){0.f, 0.f, 0.f, 0.f};
#pragma unroll
        for (int ai = 0; ai < 2; ++ai)
#pragma unroll
            for (int m = 0; m < 4; ++m) { bf16_t* rowp = base + (size_t)(row0 + ai * HALF + m * 16) * ldc + col0;
#pragma unroll
                for (int bj = 0; bj < 2; ++bj) { f32x4 v0 = acc[ai][bj][m][0] + bv[bj][0], v1 = acc[ai][bj][m][1] + bv[bj][1];
                    if (ACT == 1) { f32x2 a = gelu_pk((f32x2){v0[0], v0[1]}), b = gelu_pk((f32x2){v0[2], v0[3]}), c = gelu_pk((f32x2){v1[0], v1[1]}), d = gelu_pk((f32x2){v1[2], v1[3]});
                        v0 = (f32x4){a.x, a.y, b.x, b.y}; v1 = (f32x4){c.x, c.y, d.x, d.y}; }
                    if (ACT == 2) {
#pragma unroll
                        for (int j = 0; j < 4; ++j) { v0[j] = 0.5f * v0[j] * (1.0f + erff(v0[j] * 0.70710678f)); v1[j] = 0.5f * v1[j] * (1.0f + erff(v1[j] * 0.70710678f)); } }
                    u32x4 w; w.x = cvt_pk_bf16(v0[0], v0[1]); w.y = cvt_pk_bf16(v0[2], v0[3]); w.z = cvt_pk_bf16(v1[0], v1[1]); w.w = cvt_pk_bf16(v1[2], v1[3]);
                    *(u32x4*)(rowp + bj * HALF) = w; } }
    }
};
template <class Epi, class Sched, bool STAMP = false>
__device__ __forceinline__ void gemm_phase(PG8_LAS unsigned char* lds, const Gemm g, const Sched& S, const Epi& E, unsigned long long* stamps) {
    int tid_ = threadIdx.x; asm volatile("" : "+v"(tid_)); const int tid = tid_, wid = __builtin_amdgcn_readfirstlane(tid >> 6), lane = tid & 63, wr = wid >> 2, wc = wid & 3, fr = lane & 15, fq = lane >> 4;
    const int K = g.K, nt = K / BK;
    int ts_lo = 0, ts_hi = 0, nts = 0; const unsigned long long rt_entry = STAMP ? (unsigned long long)wall_clock64() : 0ull;
#define PG8_STAMP() do { if (STAMP && wid == 0 && nts < 64) { const unsigned long long _c = (unsigned long long)clock64(); \
        ts_lo = (lane == nts) ? (int)(unsigned)_c : ts_lo; ts_hi = (lane == nts) ? (int)(unsigned)(_c >> 32) : ts_hi; ++nts; } } while (0)
    PG8_STAMP();
    unsigned voffA[2], voffB[2];
#pragma unroll
    for (int i = 0; i < 2; ++i) { int R, C; stage_rc(tid * 16 + i * 8192, R, C); const int Rb = Epi::PERM ? ((R & ~31) + perm32(R & 31)) : R;
        voffA[i] = (unsigned)(R * K + C) * 2u; voffB[i] = (unsigned)(Rb * K + C) * 2u; }
    const size_t kstep = (size_t)(BK * 2);
    const size_t hstep = (size_t)HALF * K * 2;
    const size_t tstep = 2 * hstep;
    const unsigned ldsw = (unsigned)wid * 1024u;
    const int aoff = lds_byte(wr * 64 + fr, fq * 8), boff = lds_byte(wc * 32 + fr, fq * 8);
#define PG8_SA(b, h) (((b) * 2 + (h)) * HTB)
#define PG8_SB(b, h) ((4 + (b) * 2 + (h)) * HTB)
#define PG8_STAGE(bufoff, gbase, voff) do { _Pragma("unroll") for (int _i = 0; _i < 2; ++_i) \
        __builtin_amdgcn_global_load_lds((const unsigned*)((const char*)(gbase) + (voff)[_i]), (PG8_LAS unsigned*)(lds + (bufoff) + ldsw + _i * 8192), 16, 0, 0); } while (0)
#define PG8_LDA(dst, b, h) do { _Pragma("unroll") for (int m = 0; m < 4; ++m) _Pragma("unroll") for (int k = 0; k < 2; ++k) dst[m][k] = *(const PG8_LAS bf16x8*)(lds + PG8_SA(b, h) + aoff + m * 2048 + k * 1024); } while (0)
#define PG8_LDB(dst, b, h) do { _Pragma("unroll") for (int n = 0; n < 2; ++n) _Pragma("unroll") for (int k = 0; k < 2; ++k) dst[n][k] = *(const PG8_LAS bf16x8*)(lds + PG8_SB(b, h) + boff + n * 2048 + k * 1024); } while (0)
#define PG8_MMA(ai, bj, At, Bt) do { __builtin_amdgcn_s_setprio(1); _Pragma("unroll") for (int m = 0; m < 4; ++m) _Pragma("unroll") for (int n = 0; n < 2; ++n) _Pragma("unroll") for (int k = 0; k < 2; ++k) \
        acc[ai][bj][m][n] = __builtin_amdgcn_mfma_f32_16x16x32_bf16(Bt[n][k], At[m][k], acc[ai][bj][m][n], 0, 0, 0); __builtin_amdgcn_s_setprio(0); } while (0)
#define PG8_WAIT_V(n) asm volatile("s_waitcnt vmcnt(" #n ")" ::: "memory")
#define PG8_WAIT_L(n) asm volatile("s_waitcnt lgkmcnt(" #n ")" ::: "memory")
#define PG8_BAR __builtin_amdgcn_s_barrier()
#define PG8_SCHED __builtin_amdgcn_sched_barrier(0)
    Unit cur, nxt; int ui = 0;
    if (!S.next(0, cur)) return;
    f32x4 acc[2][2][4][2];
    bf16x8 At[4][2], B0[2][2], B1[2][2];
    const char* cA = (const char*)g.A + (size_t)cur.pm * tstep; const char* cB = (const char*)g.Bt + (size_t)cur.pn * tstep;
    S.a_first(cur);
#pragma unroll
    for (int a = 0; a < 2; ++a)
#pragma unroll
        for (int b = 0; b < 2; ++b)
#pragma unroll
            for (int m = 0; m < 4; ++m)
#pragma unroll
                for (int n = 0; n < 2; ++n) acc[a][b][m][n] = (f32x4){0.f, 0.f, 0.f, 0.f};
    PG8_STAGE(PG8_SB(0, 0), cB, voffB); PG8_STAGE(PG8_SA(0, 0), cA, voffA); PG8_STAGE(PG8_SB(0, 1), cB + hstep, voffB); PG8_STAGE(PG8_SA(0, 1), cA + hstep, voffA);
    if (wr == 1) PG8_BAR;
    PG8_WAIT_V(4); PG8_BAR;
    PG8_STAGE(PG8_SB(1, 0), cB + kstep, voffB); PG8_STAGE(PG8_SA(1, 0), cA + kstep, voffA); PG8_STAGE(PG8_SB(1, 1), cB + hstep + kstep, voffB);
    PG8_WAIT_V(6); PG8_BAR;
    PG8_STAMP();
    for (;;) {
        const bool has_next = S.next(ui + 1, nxt);
        const char* nA = has_next ? (const char*)g.A + (size_t)nxt.pm * tstep : cA; const char* nB = has_next ? (const char*)g.Bt + (size_t)nxt.pn * tstep : cB;
        for (int t = 0; t < nt; t += 2) {
            const bool last = (t == nt - 2);
            const char* a1 = cA + (size_t)(t + 1) * kstep;
            const char* a2 = last ? nA : cA + (size_t)(t + 2) * kstep; const char* b2 = last ? nB : cB + (size_t)(t + 2) * kstep;
            const char* a3 = a2 + kstep; const char* b3 = b2 + kstep;
            if (last && has_next) S.a_ready(nxt);
            PG8_LDB(B0, 0, 0); PG8_SCHED; PG8_LDA(At, 0, 0); PG8_STAGE(PG8_SA(1, 1), a1 + hstep, voffA);
            PG8_WAIT_L(8); PG8_BAR; PG8_WAIT_L(0); PG8_MMA(0, 0, At, B0); PG8_BAR; PG8_SCHED;
            PG8_LDB(B1, 0, 1); PG8_STAGE(PG8_SB(0, 0), b2, voffB);
            PG8_BAR; PG8_WAIT_L(0); PG8_MMA(0, 1, At, B1); PG8_BAR;
            PG8_LDA(At, 0, 1); PG8_STAGE(PG8_SA(0, 0), a2, voffA);
            PG8_BAR; PG8_WAIT_L(0); PG8_MMA(1, 0, At, B0); PG8_BAR; PG8_SCHED;
            PG8_STAGE(PG8_SB(0, 1), b2 + hstep, voffB);
            PG8_WAIT_V(6); PG8_BAR; PG8_MMA(1, 1, At, B1); PG8_BAR;
            PG8_LDB(B0, 1, 0); PG8_SCHED; PG8_LDA(At, 1, 0); PG8_STAGE(PG8_SA(0, 1), a2 + hstep, voffA);
            PG8_WAIT_L(8); PG8_BAR; PG8_WAIT_L(0); PG8_MMA(0, 0, At, B0); PG8_BAR; PG8_SCHED;
            PG8_LDB(B1, 1, 1); PG8_STAGE(PG8_SB(1, 0), b3, voffB);
            PG8_BAR; PG8_WAIT_L(0); PG8_MMA(0, 1, At, B1); PG8_BAR;
            PG8_LDA(At, 1, 1); PG8_STAGE(PG8_SA(1, 0), a3, voffA);
            PG8_BAR; PG8_WAIT_L(0); PG8_MMA(1, 0, At, B0); PG8_BAR; PG8_SCHED;
            PG8_STAGE(PG8_SB(1, 1), b3 + hstep, voffB);
            PG8_WAIT_V(6); PG8_BAR; PG8_MMA(1, 1, At, B1); PG8_BAR;
        }
        PG8_STAMP();
        if constexpr (!Epi::AFTER_DRAIN) { E(acc, cur, wr, wc, fr, fq); S.done(cur); }
        PG8_STAMP();
        if (!has_next) break;
#pragma unroll
        for (int a = 0; a < 2; ++a)
#pragma unroll
            for (int b = 0; b < 2; ++b)
#pragma unroll
                for (int m = 0; m < 4; ++m)
#pragma unroll
                    for (int n = 0; n < 2; ++n) acc[a][b][m][n] = (f32x4){0.f, 0.f, 0.f, 0.f};
        cur = nxt; cA = nA; cB = nB; ++ui;
    }
    PG8_WAIT_V(0);
    if (wr == 0) PG8_BAR;
    PG8_BAR;
    if constexpr (Epi::AFTER_DRAIN) { E.fused(acc, cur, wr, wc, fr, fq, lds, wid, lane); S.done(cur); }
    PG8_STAMP();
    if (STAMP && wid == 0) { stamps[lane] = lane < nts ? (((unsigned long long)(unsigned)ts_hi << 32) | (unsigned)ts_lo) : 0ull;
        if (lane == 62) stamps[62] = rt_entry; if (lane == 63) stamps[63] = (unsigned long long)wall_clock64(); }
#undef PG8_STAMP
#undef PG8_SA
#undef PG8_SB
#undef PG8_STAGE
#undef PG8_LDA
#undef PG8_LDB
#undef PG8_MMA
#undef PG8_WAIT_V
#undef PG8_WAIT_L
#undef PG8_BAR
#undef PG8_SCHED
}
}
#define LAS __attribute__((address_space(3)))
typedef unsigned short bf16;
typedef float f32x4 __attribute__((ext_vector_type(4)));
typedef unsigned v4u __attribute__((ext_vector_type(4)));
typedef unsigned v2u __attribute__((ext_vector_type(2)));
typedef short bf16x8 __attribute__((ext_vector_type(8)));
constexpr int T = 16384, D = 1024, NP = 2816, FH = 3072, F2 = 6144, DEPTH = 4, NCH = 256  ;
constexpr int C_Q = 0, C_K = 256, C_V = 512, C_G = 1024, C_GATE = 1536, C_LX = 1792, C_LY = 2304;
constexpr int DIN = 2576, O_A = 1536, O_X = 1552;
constexpr float EPS = 1e-6f;
constexpr size_t MiB = 1u << 20;
constexpr size_t WS_WIN = 1 * MiB, WS_WOUT = 7 * MiB, WS_WFI = 9 * MiB, WS_WDN = 21 * MiB, WS_U = 27 * MiB, WS_MIX = 59 * MiB, WS_BIG = 91 * MiB;
constexpr size_t WS_PROJ = WS_BIG, WS_GU = WS_BIG + 88 * MiB, WS_HLOC = WS_GU + 32 * MiB, WS_PCUM = WS_HLOC + 32 * MiB, WS_SMALL = WS_PCUM + 32 * MiB;
constexpr size_t WS_DEC = WS_SMALL, WS_AEND = WS_SMALL + 256 * 1024, WS_HEND = WS_AEND + 512 * 1024, WS_HIN = WS_HEND + 512 * 1024;
constexpr size_t WS_WAT = WS_SMALL + 1792 * 1024, WS_WXT = WS_WAT + 64 * 1024, WS_SPT = WS_SMALL + 2 * MiB;
constexpr size_t WS_ACT = WS_BIG, WS_ZR = WS_BIG + 96 * MiB, WS_END = WS_SPT + 16 * MiB;
static_assert(WS_ZR + 24 * MiB <= WS_END, "ws map");
constexpr size_t WS_SSA = 296 * MiB, WS_SSB = 297 * MiB, WS_SA = 298 * MiB, WS_SB = WS_SA + 65536;
constexpr int LDS_BYTES = 147456;

__device__ __forceinline__ unsigned f2bf(float f) { unsigned u = __builtin_bit_cast(unsigned, f); return (u + 0x7fffu + ((u >> 16) & 1u)) >> 16; }
__device__ __forceinline__ unsigned pk2(float lo, float hi) { return f2bf(lo) | (f2bf(hi) << 16); }
__device__ __forceinline__ float bf2f(bf16 b) { return __builtin_bit_cast(float, (unsigned)b << 16); }
__device__ __forceinline__ float bflo(unsigned w) { return __builtin_bit_cast(float, w << 16); }
__device__ __forceinline__ float bfhi(unsigned w) { return __builtin_bit_cast(float, w & 0xffff0000u); }
__device__ __forceinline__ float sigmoidf_(float x) { return __builtin_amdgcn_rcpf(1.0f + __builtin_amdgcn_exp2f(-1.4426950408889634f * x)); }
__device__ __forceinline__ float gelu_tanh(float x) { const float y = x * (0.7978845608028654f + 0.035677408136300125f * x * x); return x * __builtin_amdgcn_rcpf(1.0f + __builtin_amdgcn_exp2f(-2.885390081777927f * y)); }
__device__ __forceinline__ float log_sigmoid(float x) { return fminf(x, 0.0f) - 0.6931471805599453f * __builtin_amdgcn_logf(1.0f + __builtin_amdgcn_exp2f(-1.4426950408889634f * fabsf(x))); }
__device__ __forceinline__ float wave_sum(float v) {
#pragma unroll
    for (int o = 1; o < 64; o <<= 1) v += __shfl_xor(v, o);
    return v;
}
#define LDS_WAIT() asm volatile("s_waitcnt lgkmcnt(0)" ::: "memory")

__device__ __forceinline__ float row_ss(const float* ss, int row) { const f32x4* p = (const f32x4*)(ss + (size_t)row * 16); const f32x4 a = (p[0] + p[1]) + (p[2] + p[3]); return (a.x + a.y) + (a.z + a.w); }
struct EpiRes {
    static constexpr bool PERM = true, AFTER_DRAIN = false;
    bf16* h; float* ss;
    __device__ __forceinline__ void operator()(const f32x4 (&acc)[2][2][4][2], const pg8::Unit& u, int wr, int wc, int fr_, int fq_) const {
        int ln_ = threadIdx.x; asm volatile("" : "+v"(ln_)); const int fr = ln_ & 15, fq = (ln_ >> 4) & 3; (void)fr_; (void)fq_;
        const int row0 = u.pm * 256 + wr * 64 + fr, col0 = u.pn * 256 + wc * 32 + 8 * fq;
#pragma unroll
        for (int ai = 0; ai < 2; ++ai) { v4u bv[4][2];
#pragma unroll
            for (int m = 0; m < 4; ++m)
#pragma unroll
                for (int bj = 0; bj < 2; ++bj) bv[m][bj] = *(const v4u*)(h + (size_t)(row0 + ai * 128 + m * 16) * D + col0 + bj * 128);
#pragma unroll
            for (int m = 0; m < 4; ++m) { const int row = row0 + ai * 128 + m * 16; float q = 0.f;
#pragma unroll
                for (int bj = 0; bj < 2; ++bj) { const v4u x = bv[m][bj]; const f32x4 a0 = acc[ai][bj][m][0], a1 = acc[ai][bj][m][1];
                    const float o0 = bflo(x.x) + a0[0], o1 = bfhi(x.x) + a0[1], o2 = bflo(x.y) + a0[2], o3 = bfhi(x.y) + a0[3], o4 = bflo(x.z) + a1[0], o5 = bfhi(x.z) + a1[1], o6 = bflo(x.w) + a1[2], o7 = bfhi(x.w) + a1[3];
                    q += ((o0 * o0 + o1 * o1) + (o2 * o2 + o3 * o3)) + ((o4 * o4 + o5 * o5) + (o6 * o6 + o7 * o7));
                    v4u w; w.x = pg8::cvt_pk_bf16(o0, o1); w.y = pg8::cvt_pk_bf16(o2, o3); w.z = pg8::cvt_pk_bf16(o4, o5); w.w = pg8::cvt_pk_bf16(o6, o7);
                    *(v4u*)(h + (size_t)row * D + col0 + bj * 128) = w; }
                q += __shfl_xor(q, 16); q += __shfl_xor(q, 32);
                if (fq == 0) ss[(size_t)row * 16 + u.pn * 4 + wc] = q; } }
    }
};
struct EpiBf16S {
    static constexpr bool PERM = true, AFTER_DRAIN = false;
    bf16* O; int ldc; const LAS float* tab; mutable int k;
    __device__ __forceinline__ void operator()(const f32x4 (&acc)[2][2][4][2], const pg8::Unit& u, int wr, int wc, int fr_, int fq_) const {
        int ln_ = threadIdx.x; asm volatile("" : "+v"(ln_)); const int fr = ln_ & 15, fq = (ln_ >> 4) & 3; (void)fr_; (void)fq_;
        const int row0 = u.pm * 256 + wr * 64 + fr, col0 = u.pn * 256 + wc * 32 + 8 * fq;
        const LAS float* tb = tab + (k & 1) * 256; ++k;
        float s[2][4];
#pragma unroll
        for (int ai = 0; ai < 2; ++ai)
#pragma unroll
            for (int m = 0; m < 4; ++m) s[ai][m] = tb[wr * 64 + fr + ai * 128 + m * 16];
#pragma unroll
        for (int ai = 0; ai < 2; ++ai)
#pragma unroll
            for (int m = 0; m < 4; ++m) { bf16* rowp = O + (size_t)(row0 + ai * 128 + m * 16) * ldc + col0;
#pragma unroll
                for (int bj = 0; bj < 2; ++bj) { const f32x4 v0 = acc[ai][bj][m][0] * s[ai][m], v1 = acc[ai][bj][m][1] * s[ai][m];
                    v4u w; w.x = pg8::cvt_pk_bf16(v0[0], v0[1]); w.y = pg8::cvt_pk_bf16(v0[2], v0[3]); w.z = pg8::cvt_pk_bf16(v1[0], v1[1]); w.w = pg8::cvt_pk_bf16(v1[2], v1[3]);
                    *(v4u*)(rowp + bj * 128) = w; } }
    }
};

__device__ __forceinline__ float dpp_ror1(float x) { return __builtin_bit_cast(float, __builtin_amdgcn_update_dpp(0, __builtin_bit_cast(int, x), 0x121, 0xf, 0xf, false)); }
__device__ __forceinline__ float dpp_ror2(float x) { return __builtin_bit_cast(float, __builtin_amdgcn_update_dpp(0, __builtin_bit_cast(int, x), 0x122, 0xf, 0xf, false)); }
__device__ __forceinline__ float gelu_fast(float x) { const float y = x * (0.7978845608028654f + 0.035677408136300125f * x * x); return x * __builtin_amdgcn_rcpf(1.0f + __builtin_amdgcn_exp2f(-2.885390081777927f * y)); }

struct EpiFfn {
    static constexpr bool PERM = true, AFTER_DRAIN = false;
    bf16* act; bf16* zr; const LAS float* tab; mutable int k;
    __device__ __forceinline__ void operator()(const f32x4 (&acc_)[2][2][4][2], const pg8::Unit& u, int wr, int wc, int fr_, int fq_) const {
        int ln_ = threadIdx.x; asm volatile("" : "+v"(ln_)); const int fr = ln_ & 15, fq = (ln_ >> 4) & 3; (void)fr_; (void)fq_;
        f32x4 (&acc)[2][2][4][2] = const_cast<f32x4 (&)[2][2][4][2]>(acc_);
        const bool f0 = (fr == 0), f01 = (fr < 2);
        const LAS float* tb = tab + (k & 1) * 1280; ++k;
        float srow[2][4];
#pragma unroll
        for (int ai = 0; ai < 2; ++ai)
#pragma unroll
            for (int m = 0; m < 4; ++m) srow[ai][m] = tb[1024 + ai * 128 + wr * 64 + m * 16 + fr];
        typedef float f32x2_ __attribute__((ext_vector_type(2)));
        const int jl = wc * 32 + 8 * fq, ch = u.pn * 128 + jl;
        f32x4 wA[2][3], wG[2][3], bA[2], bG[2];
#pragma unroll
        for (int n = 0; n < 2; ++n) {
#pragma unroll
            for (int j = 0; j < 3; ++j) { wA[n][j] = *(const LAS f32x4*)(tb + j * 256 + jl + 4 * n); wG[n][j] = *(const LAS f32x4*)(tb + j * 256 + 128 + jl + 4 * n); }
            bA[n] = *(const LAS f32x4*)(tb + 768 + jl + 4 * n); bG[n] = *(const LAS f32x4*)(tb + 768 + 128 + jl + 4 * n); }
#pragma unroll
        for (int ai = 0; ai < 2; ++ai)
#pragma unroll
            for (int m = 0; m < 4; ++m)
#pragma unroll
                for (int bj = 0; bj < 2; ++bj)
#pragma unroll
                    for (int n = 0; n < 2; ++n) acc[ai][bj][m][n] *= srow[ai][m];
#pragma unroll
        for (int ai = 0; ai < 2; ++ai) { const int gb = u.pm * 4 + ai * 2 + wr;
            if (fr < 2) { bf16* z = zr + ((size_t)gb * 4 + fr) * F2 + u.pn * 256 + jl; const f32x4 a0 = acc[ai][0][0][0], a1 = acc[ai][0][0][1], g0 = acc[ai][1][0][0], g1 = acc[ai][1][0][1];
                *(v4u*)z = (v4u){pg8::cvt_pk_bf16(a0[0], a0[1]), pg8::cvt_pk_bf16(a0[2], a0[3]), pg8::cvt_pk_bf16(a1[0], a1[1]), pg8::cvt_pk_bf16(a1[2], a1[3])};
                *(v4u*)(z + 128) = (v4u){pg8::cvt_pk_bf16(g0[0], g0[1]), pg8::cvt_pk_bf16(g0[2], g0[3]), pg8::cvt_pk_bf16(g1[0], g1[1]), pg8::cvt_pk_bf16(g1[2], g1[3])}; }
            if (fr >= 14) { bf16* z = zr + ((size_t)gb * 4 + (fr - 12)) * F2 + u.pn * 256 + jl; const f32x4 a0 = acc[ai][0][3][0], a1 = acc[ai][0][3][1], g0 = acc[ai][1][3][0], g1 = acc[ai][1][3][1];
                *(v4u*)z = (v4u){pg8::cvt_pk_bf16(a0[0], a0[1]), pg8::cvt_pk_bf16(a0[2], a0[3]), pg8::cvt_pk_bf16(a1[0], a1[1]), pg8::cvt_pk_bf16(a1[2], a1[3])};
                *(v4u*)(z + 128) = (v4u){pg8::cvt_pk_bf16(g0[0], g0[1]), pg8::cvt_pk_bf16(g0[2], g0[3]), pg8::cvt_pk_bf16(g1[0], g1[1]), pg8::cvt_pk_bf16(g1[2], g1[3])}; }
            unsigned outw[4][2][2];
#pragma unroll
            for (int n = 0; n < 2; ++n)
#pragma unroll
                for (int ip = 0; ip < 2; ++ip) {
                    const f32x2_ wa0 = (f32x2_){wA[n][0][2 * ip], wA[n][0][2 * ip + 1]}, wa1 = (f32x2_){wA[n][1][2 * ip], wA[n][1][2 * ip + 1]}, wa2 = (f32x2_){wA[n][2][2 * ip], wA[n][2][2 * ip + 1]}, ba = (f32x2_){bA[n][2 * ip], bA[n][2 * ip + 1]};
                    const f32x2_ wg0 = (f32x2_){wG[n][0][2 * ip], wG[n][0][2 * ip + 1]}, wg1 = (f32x2_){wG[n][1][2 * ip], wG[n][1][2 * ip + 1]}, wg2 = (f32x2_){wG[n][2][2 * ip], wG[n][2][2 * ip + 1]}, bg = (f32x2_){bG[n][2 * ip], bG[n][2 * ip + 1]};
                    f32x2_ pa1 = (f32x2_){0.f, 0.f}, pa2 = pa1, pg1 = pa1, pg2 = pa1;
#pragma unroll
                    for (int m = 0; m < 4; ++m) { f32x2_ ca, cg, ra1, ra2, rg1, rg2, za, zg;
                        ca.x = acc[ai][0][m][n][2 * ip]; ca.y = acc[ai][0][m][n][2 * ip + 1]; cg.x = acc[ai][1][m][n][2 * ip]; cg.y = acc[ai][1][m][n][2 * ip + 1];
                        ra1.x = dpp_ror1(ca.x); ra1.y = dpp_ror1(ca.y); ra2.x = dpp_ror2(ca.x); ra2.y = dpp_ror2(ca.y); rg1.x = dpp_ror1(cg.x); rg1.y = dpp_ror1(cg.y); rg2.x = dpp_ror2(cg.x); rg2.y = dpp_ror2(cg.y);
                        const f32x2_ a1 = f0 ? pa1 : ra1, a2 = f01 ? pa2 : ra2, g1 = f0 ? pg1 : rg1, g2 = f01 ? pg2 : rg2;
                        za = ba + wa0 * a2 + wa1 * a1 + wa2 * ca; zg = bg + wg0 * g2 + wg1 * g1 + wg2 * cg;
                        pa1 = ra1; pa2 = ra2; pg1 = rg1; pg2 = rg2;
                        outw[m][n][ip] = pg8::cvt_pk_bf16(gelu_fast(za.x) * zg.x, gelu_fast(za.y) * zg.y); } }
#pragma unroll
            for (int m = 0; m < 4; ++m) { v4u w; w.x = outw[m][0][0]; w.y = outw[m][0][1]; w.z = outw[m][1][0]; w.w = outw[m][1][1];
                if (m > 0 || !f01) *(v4u*)(act + (size_t)(u.pm * 256 + ai * 128 + wr * 64 + m * 16 + fr) * FH + ch) = w; }
        }
    }
};


struct ScOrder : pg8::StaticOrder {
    const float* sc; LAS unsigned char* tab; mutable int k;
    __device__ __forceinline__ void a_ready(const pg8::Unit& u) const {
        int t_ = threadIdx.x; asm volatile("" : "+v"(t_));
        if (__builtin_amdgcn_readfirstlane(t_ >> 6) == 0) __builtin_amdgcn_global_load_lds((const unsigned*)(sc + u.pm * 256 + 4 * (t_ & 63)), (LAS unsigned*)(tab + (k & 1) * 1024), 16, 0, 0);
        ++k;
    }
    __device__ __forceinline__ void a_first(const pg8::Unit& u) const { a_ready(u); }
};
struct FfnOrder : pg8::StaticOrder {
    const float* cw; const float* cb; const float* sc; LAS unsigned char* tab; mutable int k;
    __device__ __forceinline__ void a_ready(const pg8::Unit& u) const {
        int t_ = threadIdx.x; asm volatile("" : "+v"(t_));
        const int wid = __builtin_amdgcn_readfirstlane(t_ >> 6), lane = t_ & 63;
        if (wid < 5) { const float* src;
            if (wid < 4) src = ((wid < 3) ? cw + (size_t)wid * F2 : cb) + ((lane < 32) ? u.pn * 128 + 4 * lane : FH + u.pn * 128 + 4 * (lane - 32));
            else src = sc + u.pm * 256 + 4 * lane;
            __builtin_amdgcn_global_load_lds((const unsigned*)src, (LAS unsigned*)(tab + (k & 1) * 5120 + wid * 1024), 16, 0, 0); }
        ++k;
    }
    __device__ __forceinline__ void a_first(const pg8::Unit& u) const { a_ready(u); }
};
__device__ __forceinline__ f32x4 ld4bf(const bf16* p) { const v2u w = *(const v2u*)p; return (f32x4){bflo(w.x), bfhi(w.x), bflo(w.y), bfhi(w.y)}; }
struct FixOrder : pg8::StaticOrder {
    bf16* act; const bf16* zr; const float* cw; const float* cb;
    __device__ __forceinline__ void a_first(const pg8::Unit& u) const {
        int t_ = threadIdx.x; asm volatile("" : "+v"(t_));
        if (t_ < 384) { const int j = 8 * t_, colA = (j >> 7) * 256 + (j & 127);
            f32x4 wa[3][2], wg[3][2], ba[2], bg[2];
#pragma unroll
            for (int hv = 0; hv < 2; ++hv) { ba[hv] = *(const f32x4*)(cb + j + 4 * hv); bg[hv] = *(const f32x4*)(cb + FH + j + 4 * hv);
#pragma unroll
                for (int tp = 0; tp < 3; ++tp) { wa[tp][hv] = *(const f32x4*)(cw + tp * F2 + j + 4 * hv); wg[tp][hv] = *(const f32x4*)(cw + tp * F2 + FH + j + 4 * hv); } }
#pragma unroll 1
            for (int qp = 0; qp < 2; ++qp) { f32x4 z[2][4][2][2];
#pragma unroll
                for (int qq = 0; qq < 2; ++qq) { const int gb = u.pm * 4 + 2 * qp + qq; const bf16* zc = zr + (size_t)gb * 4 * F2 + colA;
#pragma unroll
                    for (int rw = 0; rw < 4; ++rw) { const bf16* zrow = zc + (ptrdiff_t)(rw - 2) * F2;
#pragma unroll
                        for (int ag = 0; ag < 2; ++ag)
#pragma unroll
                            for (int hv = 0; hv < 2; ++hv) z[qq][rw][ag][hv] = (rw < 2 && gb == 0) ? (f32x4){0.f, 0.f, 0.f, 0.f} : ld4bf(zrow + 128 * ag + 4 * hv); } }
#pragma unroll
                for (int qq = 0; qq < 2; ++qq) { const int gb = u.pm * 4 + 2 * qp + qq;
#pragma unroll
                    for (int rr2 = 0; rr2 < 2; ++rr2) { unsigned ow[4];
#pragma unroll
                        for (int hv = 0; hv < 2; ++hv) { const f32x4 za = ba[hv] + wa[0][hv] * z[qq][rr2][0][hv] + wa[1][hv] * z[qq][rr2 + 1][0][hv] + wa[2][hv] * z[qq][rr2 + 2][0][hv];
                            const f32x4 zg = bg[hv] + wg[0][hv] * z[qq][rr2][1][hv] + wg[1][hv] * z[qq][rr2 + 1][1][hv] + wg[2][hv] * z[qq][rr2 + 2][1][hv];
                            ow[2 * hv] = pg8::cvt_pk_bf16(gelu_fast(za[0]) * zg[0], gelu_fast(za[1]) * zg[1]); ow[2 * hv + 1] = pg8::cvt_pk_bf16(gelu_fast(za[2]) * zg[2], gelu_fast(za[3]) * zg[3]); }
                        v4u w; w.x = ow[0]; w.y = ow[1]; w.z = ow[2]; w.w = ow[3]; *(v4u*)(act + (size_t)(64 * gb + rr2) * FH + j) = w; } } } }
        asm volatile("s_waitcnt vmcnt(0)" ::: "memory"); __builtin_amdgcn_s_barrier(); asm volatile("" ::: "memory");
    }
    __device__ __forceinline__ void a_ready(const pg8::Unit& u) const {
        int tl_ = threadIdx.x; asm volatile("" : "+v"(tl_));
        for (int it = tl_; it < 3072; it += 512) { const int j8 = it % 384, rq = it / 384, q = rq >> 1, rr2 = rq & 1, gb = u.pm * 4 + q, j = 8 * j8, colA = (j >> 7) * 256 + (j & 127);
            const bf16* zc = zr + (size_t)gb * 4 * F2 + colA; const bf16* zp = zc - 4 * F2;
            const bf16* r2 = rr2 ? zp + 3 * F2 : zp + 2 * F2; const bf16* r1 = rr2 ? zc : zp + 3 * F2; const bf16* r0 = rr2 ? zc + F2 : zc;
            const bool z2 = (gb == 0), z1 = (gb == 0) && (rr2 == 0);
            unsigned ow[4];
#pragma unroll
            for (int hv = 0; hv < 2; ++hv) { const int o = 4 * hv; const f32x4 zz = (f32x4){0.f, 0.f, 0.f, 0.f};
                const f32x4 a2 = z2 ? zz : ld4bf(r2 + o), a1 = z1 ? zz : ld4bf(r1 + o), a0 = ld4bf(r0 + o);
                const f32x4 g2 = z2 ? zz : ld4bf(r2 + 128 + o), g1 = z1 ? zz : ld4bf(r1 + 128 + o), g0 = ld4bf(r0 + 128 + o);
                const f32x4 wa0 = *(const f32x4*)(cw + j + o), wa1 = *(const f32x4*)(cw + F2 + j + o), wa2 = *(const f32x4*)(cw + 2 * F2 + j + o), ba = *(const f32x4*)(cb + j + o);
                const f32x4 wg0 = *(const f32x4*)(cw + FH + j + o), wg1 = *(const f32x4*)(cw + F2 + FH + j + o), wg2 = *(const f32x4*)(cw + 2 * F2 + FH + j + o), bg = *(const f32x4*)(cb + FH + j + o);
                const f32x4 za = ba + wa0 * a2 + wa1 * a1 + wa2 * a0, zg = bg + wg0 * g2 + wg1 * g1 + wg2 * g0;
                ow[2 * hv] = pg8::cvt_pk_bf16(gelu_fast(za[0]) * zg[0], gelu_fast(za[1]) * zg[1]); ow[2 * hv + 1] = pg8::cvt_pk_bf16(gelu_fast(za[2]) * zg[2], gelu_fast(za[3]) * zg[3]); }
            v4u w; w.x = ow[0]; w.y = ow[1]; w.z = ow[2]; w.w = ow[3]; *(v4u*)(act + (size_t)(64 * gb + rr2) * FH + j) = w; }
        asm volatile("s_waitcnt vmcnt(0)" ::: "memory"); __builtin_amdgcn_s_barrier(); asm volatile("" ::: "memory");
    }
};

__device__ __forceinline__ void transpose_item(const float* W, int ldw, bf16* WT, int K, LAS float* scr, int kb, int nb, int lane, const float* gk = nullptr) {
    const int k0 = 64 * kb, n0 = 32 * nb;
    float tv[32]; const float* wp = W + (size_t)(k0 + (lane >> 5)) * ldw + n0 + (lane & 31);
#pragma unroll
    for (int i = 0; i < 32; ++i) { tv[i] = *wp; wp += 2 * ldw; }
#pragma unroll
    for (int i = 0; i < 32; ++i) { const int kk = 2 * i + (lane >> 5); scr[kk * 33 + (lane & 31)] = tv[i] * (gk ? gk[k0 + kk] : 1.0f); }
    LDS_WAIT();
    const int c = lane & 7;
#pragma unroll
    for (int j = 0; j < 4; ++j) { const int n = (lane >> 3) + 8 * j; const LAS float* s = scr + (8 * c) * 33 + n;
        v4u o; o.x = pk2(s[0 * 33], s[1 * 33]); o.y = pk2(s[2 * 33], s[3 * 33]); o.z = pk2(s[4 * 33], s[5 * 33]); o.w = pk2(s[6 * 33], s[7 * 33]);
        *(v4u*)(WT + (size_t)(n0 + n) * K + k0 + 8 * c) = o; }
    LDS_WAIT();
}

__device__ __forceinline__ void norm_row_bf16(const float* xrow, const float* g, bf16* orow, int lane) {
    f32x4 v[2][2]; float s = 0.f;
#pragma unroll
    for (int j = 0; j < 2; ++j)
#pragma unroll
        for (int hv = 0; hv < 2; ++hv) { v[j][hv] = *(const f32x4*)(xrow + 512 * j + 8 * lane + 4 * hv); s += (v[j][hv].x * v[j][hv].x + v[j][hv].y * v[j][hv].y) + (v[j][hv].z * v[j][hv].z + v[j][hv].w * v[j][hv].w); }
    const float sc = 1.0f / sqrtf(wave_sum(s) * (1.0f / D) + EPS);
#pragma unroll
    for (int j = 0; j < 2; ++j) { const f32x4 g0 = *(const f32x4*)(g + 512 * j + 8 * lane), g1 = *(const f32x4*)(g + 512 * j + 8 * lane + 4); v4u w;
        w.x = pk2(v[j][0].x * sc * g0.x, v[j][0].y * sc * g0.y); w.y = pk2(v[j][0].z * sc * g0.z, v[j][0].w * sc * g0.w); w.z = pk2(v[j][1].x * sc * g1.x, v[j][1].y * sc * g1.y); w.w = pk2(v[j][1].z * sc * g1.z, v[j][1].w * sc * g1.w);
        *(v4u*)(orow + 512 * j + 8 * lane) = w; }
}

struct Args { const float* in[20]; float* out; unsigned char* ws; };
enum { I_X = 0, I_LNMIX, I_WIN, I_W2, I_GB, I_GNORM, I_LCW, I_LCB, I_WA, I_BA, I_WX, I_BX, I_LAM, I_WOUT, I_LNFFN, I_FWIN, I_FCW, I_FCB, I_FWDN, I_LNF };
#define XB_TMO      128
#define XB_XCNT(j)  (256  + 64 * (j))
#define XB_XSUB(j)  (1280 + 64 * (j))
#define XB_XGEN(j)  (2304 + 64 * (j))
#define XB_TOP      3328
#define XB_TOPGEN   3392
#define XCD_BAR_WORDS 3456
#define XB_SPIN_CAP (1u << 18)

__device__ __forceinline__ unsigned xb_ld(unsigned* p)              { return __hip_atomic_load(p, __ATOMIC_RELAXED, __HIP_MEMORY_SCOPE_AGENT); }
__device__ __forceinline__ unsigned xb_add(unsigned* p, unsigned v) { return __hip_atomic_fetch_add(p, v, __ATOMIC_RELAXED, __HIP_MEMORY_SCOPE_AGENT); }
__device__ __forceinline__ unsigned xb_xcc_id() { return (unsigned)__builtin_amdgcn_s_getreg((3 << 11) | 20) & 0xFu; }
#define XB_SPIN(cond, bar) do { unsigned _sp = 0; while (cond) { __builtin_amdgcn_s_sleep(1); \
    if ((++_sp & 255u) == 0u) { if (xb_ld(&(bar)[XB_TMO])) break; if (_sp > XB_SPIN_CAP) { atomicAdd(&(bar)[XB_TMO], 1u); break; } } } } while (0)

struct XcdBarrier {
    unsigned* bar; unsigned x;
    volatile LAS unsigned* st;
};

__device__ __forceinline__ XcdBarrier xcd_barrier_post(unsigned* bar, volatile LAS unsigned* st) {
    XcdBarrier b; b.bar = bar; b.x = xb_xcc_id(); b.st = st;
    if (threadIdx.x == 0) (void)xb_add(&bar[XB_XCNT(b.x)], 1u);
    return b;
}
__device__ __forceinline__ void xcd_barrier_complete(unsigned* bar, unsigned x, unsigned& nloc, unsigned& nx) {
    const unsigned G = gridDim.x * gridDim.y * gridDim.z;
    unsigned sum, cnt, mine, sp = 0u;
    for (;;) {
        sum = 0u; cnt = 0u; mine = 0u;
#pragma unroll
        for (unsigned j = 0; j < 16; ++j) { const unsigned c = xb_ld(&bar[XB_XCNT(j)]); sum += c; cnt += (c > 0u) ? 1u : 0u; mine = (j == x) ? c : mine; }
        if (sum == G) break;
        __builtin_amdgcn_s_sleep(1);
        if ((++sp & 255u) == 0u) { if (xb_ld(&bar[XB_TMO])) break; if (sp > XB_SPIN_CAP) { atomicAdd(&bar[XB_TMO], 1u); break; } }
    }
    nloc = mine > 0u ? mine : 1u; nx = cnt > 0u ? cnt : 1u;
}

__device__ __forceinline__ void xcd_barrier(const XcdBarrier& b) {
    asm volatile("s_waitcnt vmcnt(0)" ::: "memory");
    __syncthreads();
    if (threadIdx.x == 0) {
        unsigned* bar = b.bar;
        __builtin_amdgcn_s_waitcnt(0);
        unsigned nloc = b.st[0], nx = b.st[1];
        if (nloc == 0u) { xcd_barrier_complete(bar, b.x, nloc, nx); b.st[0] = nloc; b.st[1] = nx; }
        const unsigned old = xb_add(&bar[XB_XSUB(b.x)], 1u);
        const unsigned gen = old / nloc;
        if (old + 1u == (gen + 1u) * nloc) {
            __builtin_amdgcn_fence(__ATOMIC_RELEASE, "agent");
            asm volatile("s_waitcnt vmcnt(0)" ::: "memory");
            const unsigned og = xb_add(&bar[XB_TOP], 1u);
            const unsigned tg = og / nx;
            if (og + 1u == (tg + 1u) * nx) xb_add(&bar[XB_TOPGEN], 1u);
            else XB_SPIN(xb_ld(&bar[XB_TOPGEN]) == tg, bar);
            __builtin_amdgcn_fence(__ATOMIC_ACQUIRE, "agent");
            xb_add(&bar[XB_XGEN(b.x)], 1u);
            asm volatile("s_waitcnt vmcnt(0)" ::: "memory");
        } else {
            XB_SPIN(xb_ld(&bar[XB_XGEN(b.x)]) == gen, bar);
            __builtin_amdgcn_fence(__ATOMIC_ACQUIRE, "agent");
            asm volatile("s_waitcnt vmcnt(0)" ::: "memory");
        }
    }
    __syncthreads();
}
__global__ void __launch_bounds__(512, 2) trunk_fwd(Args args) {
    extern __shared__ __attribute__((aligned(16))) unsigned char lds_raw[];
    cg::grid_group grid = cg::this_grid();
    LAS unsigned char* lds = (LAS unsigned char*)lds_raw;
    LAS float* ldsf = (LAS float*)lds_raw;
    volatile LAS unsigned* bst = (volatile LAS unsigned*)(lds_raw + LDS_BYTES - 64);
    if (threadIdx.x < 16) bst[threadIdx.x] = 0u;
    __syncthreads();
    const XcdBarrier xbar = xcd_barrier_post((unsigned*)args.ws, bst);
    grid.sync();
#define GSYNC() xcd_barrier(xbar)
    const int G = gridDim.x, bid = blockIdx.x, NGW = G * 8;
    const size_t NGT = (size_t)G * 512;
#ifdef PROBE_A
    unsigned long long tl_ = __builtin_amdgcn_s_memrealtime(), ta_ = 0, tb_ = 0;
#define TICK(k) { const unsigned long long now_ = __builtin_amdgcn_s_memrealtime(); if ((k) == PROBE_A) ta_ += now_ - tl_; if ((k) == PROBE_B) tb_ += now_ - tl_; tl_ = now_; }
#else
#define TICK(k)
#endif
#define PHASE_IDS int tid_ = threadIdx.x; asm volatile("" : "+v"(tid_)); const int tid = tid_, lane = tid & 63, wave = __builtin_amdgcn_readfirstlane(tid >> 6), gw = bid * 8 + wave; const size_t gtid = (size_t)bid * 512 + tid; (void)lane; (void)gw; (void)gtid;
    unsigned char* ws = args.ws;
    bf16* Win_t = (bf16*)(ws + WS_WIN); bf16* Wout_t = (bf16*)(ws + WS_WOUT); bf16* Wfi_t = (bf16*)(ws + WS_WFI); bf16* Wdn_t = (bf16*)(ws + WS_WDN);
    bf16* U = (bf16*)(ws + WS_U); bf16* MIX = (bf16*)(ws + WS_MIX); bf16* PROJ = (bf16*)(ws + WS_PROJ); bf16* ACT = (bf16*)(ws + WS_ACT); bf16* ZR = (bf16*)(ws + WS_ZR);
    float* GU = (float*)(ws + WS_GU); unsigned* HP = (unsigned*)(ws + WS_HLOC);
    float* DEC = (float*)(ws + WS_DEC); float* AEND = (float*)(ws + WS_AEND); float* HEND = (float*)(ws + WS_HEND); float* HIN = (float*)(ws + WS_HIN);
    bf16* WAT = (bf16*)(ws + WS_WAT); bf16* WXT = (bf16*)(ws + WS_WXT); bf16* SPT = (bf16*)(ws + WS_SPT);
    float* SSA = (float*)(ws + WS_SSA); float* SSB = (float*)(ws + WS_SSB); float* SA = (float*)(ws + WS_SA); float* SB = (float*)(ws + WS_SB);
    const float* X = args.in[I_X]; float* OUT = args.out;

#pragma unroll 1
    for (int l = 0; l < DEPTH; ++l) {
        { PHASE_IDS
            LAS float* scr = ldsf + wave * 4096;
            const float* w_in = args.in[I_WIN] + (size_t)l * D * DIN; const float* w_out = args.in[I_WOUT] + (size_t)l * D * D;
            const float* fwin = args.in[I_FWIN] + (size_t)l * D * F2; const float* fwdn = args.in[I_FWDN] + (size_t)l * FH * D;
            const float* gmix = args.in[I_LNMIX] + l * D; const float* gffn = args.in[I_LNFFN] + l * D;
            constexpr int I1 = 16 * 48, I2 = 16 * 32, I3 = 16 * 32, I4 = 16 * 192, I5 = 48 * 32, NIT = I1 + I2 + I3 + I4 + I5;
            for (int it = gw; it < NIT; it += NGW) {
                int r = it;
                if (r < I1) { transpose_item(w_in, DIN, Win_t, D, scr, r / 48, r % 48, lane, gmix); continue; } r -= I1;
                if (r < I2) { transpose_item(w_in + O_X, DIN, Win_t + (size_t)C_LX * D, D, scr, r / 32, r % 32, lane, gmix); continue; } r -= I2;
                if (r < I3) { transpose_item(w_out, D, Wout_t, D, scr, r / 32, r % 32, lane); continue; } r -= I3;
                if (r < I4) { const int n0 = 32 * (r % 192), jj = (n0 < FH) ? n0 : n0 - FH, dest = 256 * (jj >> 7) + ((n0 < FH) ? 0 : 128) + (jj & 127); transpose_item(fwin + n0, F2, Wfi_t + (size_t)dest * D, D, scr, r / 192, 0, lane, gffn); continue; } r -= I4;
                transpose_item(fwdn, D, Wdn_t, FH, scr, r / 32, r % 32, lane);
            }
            const float* w2 = args.in[I_W2] + (size_t)l * 16 * 256;
            for (size_t idx = gtid; idx < (size_t)256 * 1024; idx += NGT) { const int j = (int)(idx >> 10), k = (int)(idx & 1023); float a = 0.f;
#pragma unroll
                for (int r = 0; r < 16; ++r) a += w_in[(size_t)k * DIN + O_A + r] * w2[r * 256 + j];
                Win_t[(size_t)(C_GATE + j) * D + k] = (bf16)f2bf(a * gmix[k]); }
            { const float* wa = args.in[I_WA] + (size_t)l * 32768; const float* wx = args.in[I_WX] + (size_t)l * 32768;
              for (size_t idx = gtid; idx < 32768; idx += NGT) { const int blk = (int)(idx >> 12), e = (int)(idx >> 6) & 63, d = (int)idx & 63; WAT[idx] = (bf16)f2bf(wa[(blk * 64 + d) * 64 + e]); WXT[idx] = (bf16)f2bf(wx[(blk * 64 + d) * 64 + e]); } }
            if (l == 0) { for (int m = gw; m < T; m += NGW) {
                const float* xrow = X + (size_t)m * D; bf16* orow = U + (size_t)m * D; float s = 0.f;
#pragma unroll
                for (int j = 0; j < 2; ++j) { const f32x4 v0 = *(const f32x4*)(xrow + 512 * j + 8 * lane), v1 = *(const f32x4*)(xrow + 512 * j + 8 * lane + 4);
                    s += ((v0.x * v0.x + v0.y * v0.y) + (v0.z * v0.z + v0.w * v0.w)) + ((v1.x * v1.x + v1.y * v1.y) + (v1.z * v1.z + v1.w * v1.w));
                    v4u w; w.x = pk2(v0.x, v0.y); w.y = pk2(v0.z, v0.w); w.z = pk2(v1.x, v1.y); w.w = pk2(v1.z, v1.w); *(v4u*)(orow + 512 * j + 8 * lane) = w; }
                s = wave_sum(s); if (lane == 0) SA[m] = __builtin_amdgcn_rsqf(s * (1.0f / D) + EPS); } }
            else for (size_t i = gtid; i < (size_t)T; i += NGT) SA[i] = __builtin_amdgcn_rsqf(row_ss(SSA, (int)i) * (1.0f / D) + EPS);
        }
        GSYNC(); TICK(0)
        { pg8::Gemm g{U, Win_t, T, NP, D}; ScOrder S; S.init(T, NP, G, bid); S.sc = SA; S.tab = lds + 131072; S.k = 0; EpiBf16S E{PROJ, NP, (const LAS float*)(lds + 131072), 0};
          pg8::gemm_phase<EpiBf16S, ScOrder>(lds, g, S, E, nullptr); }
        GSYNC(); TICK(1)
#pragma unroll 1
        for (int n = bid; n < NCH; n += G) { PHASE_IDS
            const int t0 = 64 * n, fr = lane & 15, fq = lane >> 4;
            {
                LAS bf16* xcb = (LAS bf16*)lds;
                { const int c0 = 8 * (tid & 63), r0 = 8 * (tid >> 6); const float* cw = args.in[I_LCW] + (size_t)l * 4 * 512 + c0; const float* cbp = args.in[I_LCB] + l * 512 + c0;
                  f32x4 w[4][2], bb[2];
#pragma unroll
                  for (int hv = 0; hv < 2; ++hv) { bb[hv] = *(const f32x4*)(cbp + 4 * hv);
#pragma unroll
                      for (int j = 0; j < 4; ++j) w[j][hv] = *(const f32x4*)(cw + j * 512 + 4 * hv); }
                  v4u xr[11];
#pragma unroll
                  for (int i = 0; i < 11; ++i) { const int t = t0 + r0 - 3 + i; xr[i] = (t >= 0) ? *(const v4u*)(PROJ + (size_t)t * NP + C_LX + c0) : (v4u){0u, 0u, 0u, 0u}; }
#pragma unroll
                  for (int rr = 0; rr < 8; ++rr) { unsigned ow[4];
#pragma unroll
                      for (int p = 0; p < 4; ++p) { float lo = bb[p >> 1][2 * (p & 1)], hi = bb[p >> 1][2 * (p & 1) + 1];
#pragma unroll
                          for (int j = 0; j < 4; ++j) { const unsigned xw = (p == 0) ? xr[rr + j].x : (p == 1) ? xr[rr + j].y : (p == 2) ? xr[rr + j].z : xr[rr + j].w;
                              lo += w[j][p >> 1][2 * (p & 1)] * bflo(xw); hi += w[j][p >> 1][2 * (p & 1) + 1] * bfhi(xw); }
                          ow[p] = pk2(lo, hi); }
                      v4u o; o.x = ow[0]; o.y = ow[1]; o.z = ow[2]; o.w = ow[3]; *(LAS v4u*)(xcb + (r0 + rr) * 520 + c0) = o; } }
                __syncthreads();
                const int blk = wave;
                bf16x8 af[4][2];
#pragma unroll
                for (int mt = 0; mt < 4; ++mt)
#pragma unroll
                    for (int ks = 0; ks < 2; ++ks) af[mt][ks] = *(const LAS bf16x8*)(xcb + (16 * mt + fr) * 520 + blk * 64 + 32 * ks + 8 * fq);
#pragma unroll 1
                for (int nt = 0; nt < 4; ++nt) {
                    const int ch = blk * 64 + 16 * nt + fr;
                    const bf16* wra = WAT + ((size_t)(blk * 64 + 16 * nt + fr)) * 64 + 8 * fq; const bf16* wrx = WXT + ((size_t)(blk * 64 + 16 * nt + fr)) * 64 + 8 * fq;
                    bf16x8 ba_[2], bx_[2];
#pragma unroll
                    for (int ks = 0; ks < 2; ++ks) { ba_[ks] = *(const bf16x8*)(wra + 32 * ks); bx_[ks] = *(const bf16x8*)(wrx + 32 * ks); }
                    const float bia = args.in[I_BA][l * 512 + ch], bix = args.in[I_BX][l * 512 + ch]; const float sp8 = 8.0f * log1pf(expf(-args.in[I_LAM][l * 512 + ch]));
                    float Hc = 0.f, Pc = 1.f;
#pragma unroll
                    for (int mt = 0; mt < 4; ++mt) {
                        f32x4 ar = (f32x4){0.f, 0.f, 0.f, 0.f}, ai = ar;
#pragma unroll
                        for (int ks = 0; ks < 2; ++ks) { ar = __builtin_amdgcn_mfma_f32_16x16x32_bf16(af[mt][ks], ba_[ks], ar, 0, 0, 0); ai = __builtin_amdgcn_mfma_f32_16x16x32_bf16(af[mt][ks], bx_[ks], ai, 0, 0, 0); }
                        float hj[4], pj[4]; float Hs = 0.f, Ps = 1.f;
#pragma unroll
                        for (int j = 0; j < 4; ++j) { const int tt = 16 * mt + 4 * fq + j;
                            const float la = -sp8 * sigmoidf_(ar[j] + bia), a = __builtin_amdgcn_exp2f(1.4426950408889634f * la); float mult = __builtin_amdgcn_sqrtf(fmaxf(1.0f - a * a, 0.0f)); if (t0 + tt == 0) mult = 1.0f;
                            const float uu = mult * (sigmoidf_(ai[j] + bix) * bf2f(xcb[tt * 520 + ch]));
                            Hs = a * Hs + uu; Ps = Ps * a; hj[j] = Hs; pj[j] = Ps; }
                        float Pi = Ps, Hi = Hs;
                        { const float P1 = __shfl(Pi, (lane - 16) & 63), H1 = __shfl(Hi, (lane - 16) & 63); if (fq >= 1) { Hi = Pi * H1 + Hi; Pi = Pi * P1; } }
                        { const float P2 = __shfl(Pi, (lane - 32) & 63), H2 = __shfl(Hi, (lane - 32) & 63); if (fq >= 2) { Hi = Pi * H2 + Hi; Pi = Pi * P2; } }
                        float Pe = __shfl(Pi, (lane - 16) & 63), He = __shfl(Hi, (lane - 16) & 63); if (fq == 0) { Pe = 1.f; He = 0.f; }
                        const float h_in = Pe * Hc + He, p_in = Pc * Pe;
#pragma unroll
                        for (int j = 0; j < 4; ++j) { const size_t t = t0 + 16 * mt + 4 * fq + j; HP[t * 512 + ch] = pk2(hj[j] + pj[j] * h_in, pj[j] * p_in); }
                        const float P3 = __shfl(Pi, fr + 48), H3 = __shfl(Hi, fr + 48);
                        Hc = P3 * Hc + H3; Pc = Pc * P3;
                    }
                    if (fq == 0) { AEND[n * 512 + ch] = Pc; HEND[n * 512 + ch] = Hc; }
                }
                __syncthreads();
            }
            {
                LAS bf16* kdT = (LAS bf16*)lds; LAS bf16* vT = kdT + 4 * 64 * 72; LAS float* exch = (LAS float*)(vT + 4 * 128 * 72);
                { const int hd0 = 8 * (tid & 31), rg = tid >> 5, c0 = 4 * rg;
                  v4u gq[4], kq[4];
#pragma unroll
                  for (int r = 0; r < 4; ++r) { const bf16* pr = PROJ + (size_t)(t0 + c0 + r) * NP + hd0; gq[r] = *(const v4u*)(pr + C_GATE); kq[r] = *(const v4u*)(pr + C_K); }
                  const float* gbp = args.in[I_GB] + l * 256 + hd0; const f32x4 gb0 = *(const f32x4*)gbp, gb1 = *(const f32x4*)(gbp + 4);
                  const float gbv[8] = {gb0.x, gb0.y, gb0.z, gb0.w, gb1.x, gb1.y, gb1.z, gb1.w};
                  float cum[8], bl[4][8];
#pragma unroll
                  for (int i = 0; i < 8; ++i) cum[i] = 0.f;
#pragma unroll
                  for (int r = 0; r < 4; ++r) { const unsigned gw_[4] = {gq[r].x, gq[r].y, gq[r].z, gq[r].w};
#pragma unroll
                      for (int i = 0; i < 8; ++i) { const float x = ((i & 1) ? bfhi(gw_[i >> 1]) : bflo(gw_[i >> 1])) + gbv[i]; cum[i] += log_sigmoid(x) * (1.0f / 16.0f); bl[r][i] = cum[i]; } }
                  *(LAS f32x4*)(exch + rg * 256 + hd0) = (f32x4){cum[0], cum[1], cum[2], cum[3]}; *(LAS f32x4*)(exch + rg * 256 + hd0 + 4) = (f32x4){cum[4], cum[5], cum[6], cum[7]};
                  __syncthreads();
                  float off[8], tot[8];
#pragma unroll
                  for (int i = 0; i < 8; ++i) { off[i] = 0.f; tot[i] = 0.f; }
                  for (int g2 = 0; g2 < 16; ++g2) { const f32x4 a = *(const LAS f32x4*)(exch + g2 * 256 + hd0), b2 = *(const LAS f32x4*)(exch + g2 * 256 + hd0 + 4); const float av[8] = {a.x, a.y, a.z, a.w, b2.x, b2.y, b2.z, b2.w};
#pragma unroll
                      for (int i = 0; i < 8; ++i) { tot[i] += av[i]; if (g2 < rg) off[i] += av[i]; } }
#pragma unroll
                  for (int i = 0; i < 8; ++i) { float kd[4];
#pragma unroll
                      for (int r = 0; r < 4; ++r) { const unsigned kw = (i >> 1) == 0 ? kq[r].x : (i >> 1) == 1 ? kq[r].y : (i >> 1) == 2 ? kq[r].z : kq[r].w; const float kv = (i & 1) ? bfhi(kw) : bflo(kw);
                          kd[r] = kv * __expf(tot[i] - (off[i] + bl[r][i])); }
                      v2u w; w.x = pk2(kd[0], kd[1]); w.y = pk2(kd[2], kd[3]); *(LAS v2u*)(kdT + (hd0 + i) * 72 + c0) = w; }
                  if (rg == 0) { *(f32x4*)(DEC + n * 256 + hd0) = (f32x4){__expf(tot[0]), __expf(tot[1]), __expf(tot[2]), __expf(tot[3])}; *(f32x4*)(DEC + n * 256 + hd0 + 4) = (f32x4){__expf(tot[4]), __expf(tot[5]), __expf(tot[6]), __expf(tot[7])}; } }
#pragma unroll
                for (int it = 0; it < 8; ++it) { const int item = it * 512 + tid, c = item & 63, e8 = item >> 6; const v4u w = *(const v4u*)(PROJ + (size_t)(t0 + c) * NP + C_V + 8 * e8);
                    LAS bf16* dst = vT + (size_t)(8 * e8) * 72 + c;
                    dst[0 * 72] = (bf16)(w.x & 0xffff); dst[1 * 72] = (bf16)(w.x >> 16); dst[2 * 72] = (bf16)(w.y & 0xffff); dst[3 * 72] = (bf16)(w.y >> 16);
                    dst[4 * 72] = (bf16)(w.z & 0xffff); dst[5 * 72] = (bf16)(w.z >> 16); dst[6 * 72] = (bf16)(w.w & 0xffff); dst[7 * 72] = (bf16)(w.w >> 16); }
                __syncthreads();
                { const int h = wave >> 1, eb = 4 * (wave & 1); bf16x8 kf[4][2], vf[4][2];
#pragma unroll
                  for (int i = 0; i < 4; ++i)
#pragma unroll
                      for (int ks = 0; ks < 2; ++ks) { kf[i][ks] = *(const LAS bf16x8*)(kdT + (h * 64 + 16 * i + fr) * 72 + 32 * ks + 8 * fq); vf[i][ks] = *(const LAS bf16x8*)(vT + (h * 128 + 16 * (eb + i) + fr) * 72 + 32 * ks + 8 * fq); }
#pragma unroll
                  for (int dt = 0; dt < 4; ++dt)
#pragma unroll
                      for (int et = 0; et < 4; ++et) { f32x4 acc = (f32x4){0.f, 0.f, 0.f, 0.f};
#pragma unroll
                          for (int ks = 0; ks < 2; ++ks) acc = __builtin_amdgcn_mfma_f32_16x16x32_bf16(kf[dt][ks], vf[et][ks], acc, 0, 0, 0);
                          *(f32x4*)(GU + ((size_t)(n * 4 + h) * 128 + 16 * (eb + et) + fr) * 64 + 16 * dt + 4 * fq) = acc; } }
                __syncthreads();
            }
        }
        GSYNC(); TICK(2)
#pragma unroll 1
        for (int it = bid; it < 256; it += G) { PHASE_IDS
            LAS float* ex = ldsf;
            { const int eg = tid & 31, sg = tid >> 5, el = 128 * it + 4 * eg, hd = ((el >> 13) << 6) | (el & 63), nb = 16 * sg;
              f32x4 u[16], dc[16];
#pragma unroll
              for (int j = 0; j < 16; ++j) { u[j] = *(const f32x4*)(GU + (size_t)(nb + j) * 32768 + el); dc[j] = *(const f32x4*)(DEC + (nb + j) * 256 + hd); }
              f32x4 S = (f32x4){0.f, 0.f, 0.f, 0.f}, P = (f32x4){1.f, 1.f, 1.f, 1.f};
#pragma unroll
              for (int j = 0; j < 16; ++j) { S = dc[j] * S + u[j]; P = P * dc[j]; }
              *(LAS f32x4*)(ex + sg * 128 + 4 * eg) = S; *(LAS f32x4*)(ex + 2048 + sg * 128 + 4 * eg) = P;
              __syncthreads();
              f32x4 Sin = (f32x4){0.f, 0.f, 0.f, 0.f};
              for (int s2 = 0; s2 < sg; ++s2) Sin = *(const LAS f32x4*)(ex + 2048 + s2 * 128 + 4 * eg) * Sin + *(const LAS f32x4*)(ex + s2 * 128 + 4 * eg);
              S = Sin;
#pragma unroll
              for (int j = 0; j < 16; ++j) { v2u w; w.x = pk2(S.x, S.y); w.y = pk2(S.z, S.w); *(v2u*)(SPT + (size_t)(nb + j) * 32768 + el) = w; S = dc[j] * S + u[j]; }
              __syncthreads(); }
            if (it < 8) { const int c = 64 * it + (tid & 63), sg = tid >> 6, nb = 32 * sg; float hc = 0.f, pc = 1.f; float a[32], b[32];
#pragma unroll
                for (int j = 0; j < 32; ++j) { a[j] = AEND[(nb + j) * 512 + c]; b[j] = HEND[(nb + j) * 512 + c]; }
#pragma unroll
                for (int j = 0; j < 32; ++j) { hc = a[j] * hc + b[j]; pc = pc * a[j]; }
                ex[sg * 64 + (tid & 63)] = hc; ex[512 + sg * 64 + (tid & 63)] = pc;
                __syncthreads();
                float hin_ = 0.f;
                for (int s2 = 0; s2 < sg; ++s2) hin_ = ex[512 + s2 * 64 + (tid & 63)] * hin_ + ex[s2 * 64 + (tid & 63)];
                hc = hin_;
#pragma unroll
                for (int j = 0; j < 32; ++j) { HIN[(nb + j) * 512 + c] = hc; hc = a[j] * hc + b[j]; }
                __syncthreads(); }
        }
        GSYNC(); TICK(3)
#pragma unroll 1
        for (int n = bid; n < NCH; n += G) { PHASE_IDS
            const int t0 = 64 * n, fr = lane & 15, fq = lane >> 4;
            { const int c0 = 8 * (tid & 63), r0 = 8 * (tid >> 6); const f32x4 hc0 = *(const f32x4*)(HIN + n * 512 + c0), hc1 = *(const f32x4*)(HIN + n * 512 + c0 + 4);
#pragma unroll
              for (int tt = 0; tt < 8; ++tt) { const size_t t = t0 + r0 + tt; const v4u hp0 = *(const v4u*)(HP + t * 512 + c0), hp1 = *(const v4u*)(HP + t * 512 + c0 + 4); const v4u gw4 = *(const v4u*)(PROJ + t * NP + C_LY + c0);
                  const f32x4 hv0 = (f32x4){bflo(hp0.x), bflo(hp0.y), bflo(hp0.z), bflo(hp0.w)} + (f32x4){bfhi(hp0.x), bfhi(hp0.y), bfhi(hp0.z), bfhi(hp0.w)} * hc0;
                  const f32x4 hv1 = (f32x4){bflo(hp1.x), bflo(hp1.y), bflo(hp1.z), bflo(hp1.w)} + (f32x4){bfhi(hp1.x), bfhi(hp1.y), bfhi(hp1.z), bfhi(hp1.w)} * hc1;
                  v4u w; w.x = pk2(hv0.x * gelu_tanh(bflo(gw4.x)), hv0.y * gelu_tanh(bfhi(gw4.x))); w.y = pk2(hv0.z * gelu_tanh(bflo(gw4.y)), hv0.w * gelu_tanh(bfhi(gw4.y)));
                  w.z = pk2(hv1.x * gelu_tanh(bflo(gw4.z)), hv1.y * gelu_tanh(bfhi(gw4.z))); w.w = pk2(hv1.z * gelu_tanh(bflo(gw4.w)), hv1.w * gelu_tanh(bfhi(gw4.w)));
                  *(v4u*)(MIX + t * D + 512 + c0) = w; } }
            LAS bf16* qi = (LAS bf16*)lds; LAS bf16* ki = qi + 4 * 64 * 72; LAS bf16* vT = ki + 4 * 64 * 72; LAS bf16* As = vT + 2 * 128 * 72; LAS float* exch = (LAS float*)(As + 8 * 16 * 72);
            { const int hd0 = 8 * (tid & 31), rg = tid >> 5, c0 = 4 * rg, h = hd0 >> 6, d0 = hd0 & 63;
              v4u gq[4], qq[4], kq[4];
#pragma unroll
              for (int r = 0; r < 4; ++r) { const bf16* pr = PROJ + (size_t)(t0 + c0 + r) * NP + hd0; gq[r] = *(const v4u*)(pr + C_GATE); qq[r] = *(const v4u*)(pr + C_Q); kq[r] = *(const v4u*)(pr + C_K); }
              const float* gbp = args.in[I_GB] + l * 256 + hd0; const f32x4 gb0 = *(const f32x4*)gbp, gb1 = *(const f32x4*)(gbp + 4);
              const float gbv[8] = {gb0.x, gb0.y, gb0.z, gb0.w, gb1.x, gb1.y, gb1.z, gb1.w};
              float cum[8], bl[4][8];
#pragma unroll
              for (int i = 0; i < 8; ++i) cum[i] = 0.f;
#pragma unroll
              for (int r = 0; r < 4; ++r) { const unsigned gw_[4] = {gq[r].x, gq[r].y, gq[r].z, gq[r].w};
#pragma unroll
                  for (int i = 0; i < 8; ++i) { const float x = ((i & 1) ? bfhi(gw_[i >> 1]) : bflo(gw_[i >> 1])) + gbv[i]; cum[i] += log_sigmoid(x) * (1.0f / 16.0f); bl[r][i] = cum[i]; } }
              *(LAS f32x4*)(exch + rg * 256 + hd0) = (f32x4){cum[0], cum[1], cum[2], cum[3]}; *(LAS f32x4*)(exch + rg * 256 + hd0 + 4) = (f32x4){cum[4], cum[5], cum[6], cum[7]};
              __syncthreads();
              float off[8];
#pragma unroll
              for (int i = 0; i < 8; ++i) off[i] = 0.f;
              for (int g2 = 0; g2 < rg; ++g2) { const f32x4 a = *(const LAS f32x4*)(exch + g2 * 256 + hd0), b2 = *(const LAS f32x4*)(exch + g2 * 256 + hd0 + 4);
                  off[0] += a.x; off[1] += a.y; off[2] += a.z; off[3] += a.w; off[4] += b2.x; off[5] += b2.y; off[6] += b2.z; off[7] += b2.w; }
#pragma unroll
              for (int r = 0; r < 4; ++r) { const unsigned qw_[4] = {qq[r].x, qq[r].y, qq[r].z, qq[r].w}, kw_[4] = {kq[r].x, kq[r].y, kq[r].z, kq[r].w}; unsigned oq[4], ok[4];
#pragma unroll
                  for (int i2 = 0; i2 < 4; ++i2) { const float b0 = off[2 * i2] + bl[r][2 * i2], b1 = off[2 * i2 + 1] + bl[r][2 * i2 + 1];
                      oq[i2] = pk2(bflo(qw_[i2]) * 0.125f * __expf(b0), bfhi(qw_[i2]) * 0.125f * __expf(b1)); ok[i2] = pk2(bflo(kw_[i2]) * __expf(-b0), bfhi(kw_[i2]) * __expf(-b1)); }
                  *(LAS v4u*)(qi + (h * 64 + c0 + r) * 72 + d0) = (v4u){oq[0], oq[1], oq[2], oq[3]}; *(LAS v4u*)(ki + (h * 64 + c0 + r) * 72 + d0) = (v4u){ok[0], ok[1], ok[2], ok[3]}; } }
#pragma unroll 1
            for (int p = 0; p < 2; ++p) {
#pragma unroll
                for (int it = 0; it < 4; ++it) { const int item = it * 512 + tid, c = item & 63, e8 = item >> 6; const v4u w = *(const v4u*)(PROJ + (size_t)(t0 + c) * NP + C_V + 256 * p + 8 * e8);
                    LAS bf16* dst = vT + (size_t)(8 * e8) * 72 + c;
                    dst[0 * 72] = (bf16)(w.x & 0xffff); dst[1 * 72] = (bf16)(w.x >> 16); dst[2 * 72] = (bf16)(w.y & 0xffff); dst[3 * 72] = (bf16)(w.y >> 16);
                    dst[4 * 72] = (bf16)(w.z & 0xffff); dst[5 * 72] = (bf16)(w.z >> 16); dst[6 * 72] = (bf16)(w.w & 0xffff); dst[7 * 72] = (bf16)(w.w >> 16); }
                __syncthreads();
                { const int hh = wave >> 2, h = 2 * p + hh, ct = wave & 3; LAS bf16* Aw = As + wave * 16 * 72;
                  bf16x8 qf[2];
#pragma unroll
                  for (int ks = 0; ks < 2; ++ks) qf[ks] = *(const LAS bf16x8*)(qi + (h * 64 + 16 * ct + fr) * 72 + 32 * ks + 8 * fq);
#pragma unroll
                  for (int st = 0; st < 4; ++st) { f32x4 dacc = (f32x4){0.f, 0.f, 0.f, 0.f};
                      if (st <= ct) {
#pragma unroll
                          for (int ks = 0; ks < 2; ++ks) { const bf16x8 kf = *(const LAS bf16x8*)(ki + (h * 64 + 16 * st + fr) * 72 + 32 * ks + 8 * fq); dacc = __builtin_amdgcn_mfma_f32_16x16x32_bf16(kf, qf[ks], dacc, 0, 0, 0); }
                          if (st == ct) {
#pragma unroll
                              for (int j = 0; j < 4; ++j) if (4 * fq + j > fr) dacc[j] = 0.f; } }
                      v2u w; w.x = pk2(dacc[0], dacc[1]); w.y = pk2(dacc[2], dacc[3]); *(LAS v2u*)(Aw + fr * 72 + 16 * st + 4 * fq) = w; }
                  bf16x8 afr[2];
#pragma unroll
                  for (int ks = 0; ks < 2; ++ks) afr[ks] = *(const LAS bf16x8*)(Aw + fr * 72 + 32 * ks + 8 * fq);
                  f32x4 o[8]; float ss = 0.f;
                  const int erow = 8 * (fr >> 2) + (fr & 3);
                  const bf16* sp = SPT + ((size_t)(n * 4 + h) * 128 + erow) * 64 + 8 * fq;
#pragma unroll
                  for (int et = 0; et < 8; ++et) { f32x4 acc = (f32x4){0.f, 0.f, 0.f, 0.f};
#pragma unroll
                      for (int ks = 0; ks < 2; ++ks) { const bf16x8 vf = *(const LAS bf16x8*)(vT + (hh * 128 + erow + 32 * (et >> 1) + 4 * (et & 1)) * 72 + 32 * ks + 8 * fq); acc = __builtin_amdgcn_mfma_f32_16x16x32_bf16(vf, afr[ks], acc, 0, 0, 0); }
#pragma unroll
                      for (int ks = 0; ks < 2; ++ks) { const bf16x8 sf = *(const bf16x8*)(sp + (size_t)(32 * (et >> 1) + 4 * (et & 1)) * 64 + 32 * ks); acc = __builtin_amdgcn_mfma_f32_16x16x32_bf16(sf, qf[ks], acc, 0, 0, 0); }
                      o[et] = acc; ss += (acc[0] * acc[0] + acc[1] * acc[1]) + (acc[2] * acc[2] + acc[3] * acc[3]); }
                  ss += __shfl_xor(ss, 16); ss += __shfl_xor(ss, 32);
                  const float sc = 1.0f / sqrtf(ss * (1.0f / 128.0f) + EPS);
                  const size_t t = t0 + 16 * ct + fr; const float* gn = args.in[I_GNORM] + l * 128;
#pragma unroll
                  for (int ep = 0; ep < 4; ++ep) { const int e = 32 * ep + 8 * fq; const v4u gw4 = *(const v4u*)(PROJ + t * NP + C_G + h * 128 + e); const f32x4 ga = *(const f32x4*)(gn + e), gb4 = *(const f32x4*)(gn + e + 4);
                      const f32x4 oa = o[2 * ep], ob = o[2 * ep + 1];
                      const float g0 = bflo(gw4.x), g1 = bfhi(gw4.x), g2 = bflo(gw4.y), g3 = bfhi(gw4.y), g4 = bflo(gw4.z), g5 = bfhi(gw4.z), g6 = bflo(gw4.w), g7 = bfhi(gw4.w);
                      v4u w; w.x = pk2(oa[0] * sc * ga.x * g0 * sigmoidf_(g0), oa[1] * sc * ga.y * g1 * sigmoidf_(g1)); w.y = pk2(oa[2] * sc * ga.z * g2 * sigmoidf_(g2), oa[3] * sc * ga.w * g3 * sigmoidf_(g3));
                      w.z = pk2(ob[0] * sc * gb4.x * g4 * sigmoidf_(g4), ob[1] * sc * gb4.y * g5 * sigmoidf_(g5)); w.w = pk2(ob[2] * sc * gb4.z * g6 * sigmoidf_(g6), ob[3] * sc * gb4.w * g7 * sigmoidf_(g7));
                      *(v4u*)(MIX + t * D + h * 128 + e) = w; } }
                __syncthreads();
            }
        }
        GSYNC(); TICK(4)
        { pg8::Gemm g{MIX, Wout_t, T, D, D}; pg8::StaticOrder S; S.init(T, D, G, bid); EpiRes E{U, SSB};
          pg8::gemm_phase<EpiRes, pg8::StaticOrder>(lds, g, S, E, nullptr); }
        GSYNC(); TICK(5)
        { PHASE_IDS for (size_t i = gtid; i < (size_t)T; i += NGT) SB[i] = __builtin_amdgcn_rsqf(row_ss(SSB, (int)i) * (1.0f / D) + EPS); }
        GSYNC(); TICK(6)
        { pg8::Gemm g{U, Wfi_t, T, F2, D}; FfnOrder S; S.init(T, F2, G, bid); S.cw = args.in[I_FCW] + (size_t)l * 3 * F2; S.cb = args.in[I_FCB] + (size_t)l * F2; S.sc = SB; S.tab = lds + 131072; S.k = 0;
          EpiFfn E{ACT, ZR, (const LAS float*)(lds + 131072), 0};
          pg8::gemm_phase<EpiFfn, FfnOrder>(lds, g, S, E, nullptr); }
        GSYNC(); TICK(7)
        { pg8::Gemm g{ACT, Wdn_t, T, D, FH}; FixOrder S; S.init(T, D, G, bid); S.act = ACT; S.zr = ZR; S.cw = args.in[I_FCW] + (size_t)l * 3 * F2; S.cb = args.in[I_FCB] + (size_t)l * F2; EpiRes E{U, SSA};
          pg8::gemm_phase<EpiRes, FixOrder>(lds, g, S, E, nullptr); }
        GSYNC(); TICK(9)
#ifdef PROBE_A
        GSYNC(); TICK(10)
#endif
    }
    { PHASE_IDS const float* g = args.in[I_LNF];
      for (int m = gw; m < T; m += NGW) { const float sc = __builtin_amdgcn_rsqf(row_ss(SSA, m) * (1.0f / D) + EPS); const bf16* hr = U + (size_t)m * D; float* orow = OUT + (size_t)m * D;
#pragma unroll
          for (int j = 0; j < 2; ++j) { const v4u x = *(const v4u*)(hr + 512 * j + 8 * lane); const f32x4 g0 = *(const f32x4*)(g + 512 * j + 8 * lane), g1 = *(const f32x4*)(g + 512 * j + 8 * lane + 4);
              *(f32x4*)(orow + 512 * j + 8 * lane) = (f32x4){bflo(x.x), bfhi(x.x), bflo(x.y), bfhi(x.y)} * sc * g0; *(f32x4*)(orow + 512 * j + 8 * lane + 4) = (f32x4){bflo(x.z), bfhi(x.z), bflo(x.w), bfhi(x.w)} * sc * g1; } } }
#ifdef PROBE_A
    GSYNC(); TICK(11)
    if (blockIdx.x == 0) { const float va = (float)ta_ * 0.01f, vb = (float)tb_ * 0.01f;
        if (threadIdx.x == 0) OUT[0] += va * 0.004f + vb * 0.0f; }
#endif
}

extern "C" void kernel_launch(void* const* d_in, const int* in_sizes, int n_in, void* d_out, int out_size, void* d_ws, size_t ws_size, hipStream_t stream) {
    static int grid = 0;
    if (grid == 0) {
        if (n_in != 20 || out_size != T * D || ws_size < 299 * MiB) { fprintf(stderr, "kernel_launch: unexpected shapes: n_in %d out %d ws %zu (need %zu)\n", n_in, out_size, ws_size, (size_t)WS_END); grid = -1; return; }
        int dev = 0, cus = 0, per_cu = 0;
        hipGetDevice(&dev); hipDeviceGetAttribute(&cus, hipDeviceAttributeMultiprocessorCount, dev);
        if (hipFuncSetAttribute((const void*)trunk_fwd, hipFuncAttributeMaxDynamicSharedMemorySize, LDS_BYTES) != hipSuccess) { fprintf(stderr, "kernel_launch: hipFuncSetAttribute failed\n"); grid = -1; return; }
        if (hipOccupancyMaxActiveBlocksPerMultiprocessor(&per_cu, (const void*)trunk_fwd, 512, LDS_BYTES) != hipSuccess || per_cu < 1) { fprintf(stderr, "kernel_launch: occupancy query says %d\n", per_cu); per_cu = 1; }
        (void)hipGetLastError();
        grid = cus * per_cu; if (grid > 256) grid = 256;
    }
    if (grid < 0) return;
    if (hipMemsetAsync(d_ws, 0, 65536, stream) != hipSuccess) { fprintf(stderr, "kernel_launch: memset failed\n"); return; }
    Args a{};
    for (int i = 0; i < 20; ++i) a.in[i] = (const float*)d_in[i];
    a.out = (float*)d_out; a.ws = (unsigned char*)d_ws;
    void* kargs[] = {&a};
    hipError_t e = hipLaunchCooperativeKernel((const void*)trunk_fwd, dim3(grid), dim3(512), kargs, LDS_BYTES, stream);
    if (e != hipSuccess) fprintf(stderr, "kernel_launch: cooperative launch failed: %s (grid %d)\n", hipGetErrorString(e), grid);
}
```
